# Optimizing an MI355X kernel written in HIP

```python
import math
import jax, jax.numpy as jnp
from jax import lax
import numpy as np

D_MODEL = 2048
BATCH = 4
SEQ = 4096
DEPTH = 1

N_ATTN_HEADS = 8
ATTN_QK_DIM = 64
ATTN_V_DIM = 2 * ATTN_QK_DIM
ATTN_QK_WIDTH = N_ATTN_HEADS * 2 * ATTN_QK_DIM
ATTN_WIDTH = N_ATTN_HEADS * ATTN_V_DIM
Q_BLOCK = 128
SG_WIDTH = D_MODEL // 2
N_SG_GROUPS = 8
SG_GROUP_DIM = SG_WIDTH // N_SG_GROUPS
SG_CHUNK = 128
N_BRANCHES = 2
D_FF = 4 * D_MODEL
Q_OFF = 0
K_OFF = Q_OFF + ATTN_QK_WIDTH
V_OFF = K_OFF + ATTN_QK_WIDTH
U_OFF = V_OFF + ATTN_WIDTH
SGV_OFF = U_OFF + SG_WIDTH
GATE_OFF = SGV_OFF + SG_WIDTH
IN_WIDTH = GATE_OFF + N_BRANCHES * D_MODEL
DEEPNORM_ALPHA = (2.0 * DEPTH) ** 0.25
DEEPNORM_BETA = (8.0 * DEPTH) ** -0.25
LN_EPS = 1e-5

kernel_name = "hybrid_diffattn_sgu_gated_deepnorm_block"


def layer_norm(x, g, b):
    xf = x.astype(jnp.float32)
    mu = jnp.mean(xf, axis=-1, keepdims=True)
    var = jnp.mean(jnp.square(xf - mu), axis=-1, keepdims=True)
    y = (xf - mu) * lax.rsqrt(var + LN_EPS) * g.astype(jnp.float32) + b.astype(jnp.float32)
    return y.astype(x.dtype)


def alibi_slopes(n_heads):
    i = jnp.arange(1, n_heads + 1, dtype=jnp.float32)
    return jnp.exp2(-8.0 * i / n_heads)


def diff_attention(q, k, v, lam, lambda_init, sub_gain):
    B, S, H, _, dk = q.shape
    nb = S // Q_BLOCK
    slopes = alibi_slopes(H)
    k_pos = jnp.arange(S, dtype=jnp.float32)
    scale = dk ** -0.5
    q_blocks = q.reshape(B, nb, Q_BLOCK, H, 2, dk).transpose(1, 0, 2, 3, 4, 5)

    def one_block(args):
        q_blk, i = args
        q_pos = (i * Q_BLOCK + jnp.arange(Q_BLOCK)).astype(jnp.float32)
        dist = jnp.abs(q_pos[:, None] - k_pos[None, :])
        bias = -slopes[:, None, None] * dist[None]
        s = jnp.einsum('bqhcd,bkhcd->bhcqk', q_blk, k,
                       preferred_element_type=jnp.float32) * scale
        p = jax.nn.softmax(s + bias[None, :, None], axis=-1)
        w = p[:, :, 0] - lam * p[:, :, 1]
        return jnp.einsum('bhqk,bkhd->bqhd', w.astype(v.dtype), v)

    o = lax.map(one_block, (q_blocks, jnp.arange(nb)))
    o = o.transpose(1, 0, 2, 3, 4).reshape(B, S, H, v.shape[-1])
    of = o.astype(jnp.float32)
    of = of * lax.rsqrt(jnp.mean(jnp.square(of), axis=-1, keepdims=True) + LN_EPS)
    of = of * sub_gain.astype(jnp.float32) * (1.0 - lambda_init)
    return of.astype(v.dtype).reshape(B, S, H * v.shape[-1])


def spatial_gating(u, v, ln_g, ln_b, w_s, b_s):
    B, S, _ = v.shape
    v = layer_norm(v, ln_g, ln_b)
    vc = v.reshape(B, S // SG_CHUNK, SG_CHUNK, N_SG_GROUPS, SG_GROUP_DIM)
    mixed = jnp.einsum('gts,bcsgd->bctgd', w_s, vc) + b_s.T[:, :, None]
    return u * mixed.reshape(B, S, SG_WIDTH)


def setup_inputs(seed: int = 0) -> dict:
    key = jax.random.key(seed)
    ks = jax.random.split(key, 24)
    f32 = jnp.float32
    L, D = DEPTH, D_MODEL

    def nrm(k, shape, scale):
        return jax.random.normal(k, shape, f32) * scale

    return {
        "x": jax.random.normal(ks[0], (BATCH, SEQ, D), f32),
        "w_in": nrm(ks[1], (L, D, IN_WIDTH), D ** -0.5),
        "lambda_q1": nrm(ks[2], (L, ATTN_QK_DIM), 0.1),
        "lambda_k1": nrm(ks[3], (L, ATTN_QK_DIM), 0.1),
        "lambda_q2": nrm(ks[4], (L, ATTN_QK_DIM), 0.1),
        "lambda_k2": nrm(ks[5], (L, ATTN_QK_DIM), 0.1),
        "attn_subln_g": 1.0 + nrm(ks[6], (L, ATTN_V_DIM), 0.02),
        "sg_ln_g": 1.0 + nrm(ks[7], (L, SG_WIDTH), 0.02),
        "sg_ln_b": nrm(ks[8], (L, SG_WIDTH), 0.02),
        "sg_w_s": nrm(ks[9], (L, N_SG_GROUPS, SG_CHUNK, SG_CHUNK), SG_CHUNK ** -0.5),
        "sg_b_s": 1.0 + nrm(ks[10], (L, N_SG_GROUPS, SG_CHUNK), 0.02),
        "b_gate": nrm(ks[11], (L, N_BRANCHES * D), 0.02),
        "w_branch_attn": nrm(ks[12], (L, ATTN_WIDTH, D), ATTN_WIDTH ** -0.5),
        "w_branch_sg": nrm(ks[13], (L, SG_WIDTH, D), SG_WIDTH ** -0.5),
        "w_o": nrm(ks[14], (L, D, D), D ** -0.5 * DEEPNORM_BETA),
        "ln1_g": 1.0 + nrm(ks[15], (L, D), 0.02),
        "ln1_b": nrm(ks[16], (L, D), 0.02),
        "w_up": nrm(ks[17], (L, D, D_FF), D ** -0.5),
        "w_down": nrm(ks[18], (L, D_FF, D), D_FF ** -0.5 * DEEPNORM_BETA),
        "ln2_g": 1.0 + nrm(ks[19], (L, D), 0.02),
        "ln2_b": nrm(ks[20], (L, D), 0.02),
    }


def reference(x, w_in, lambda_q1, lambda_k1, lambda_q2, lambda_k2, attn_subln_g,
              sg_ln_g, sg_ln_b, sg_w_s, sg_b_s, b_gate, w_branch_attn, w_branch_sg,
              w_o, ln1_g, ln1_b, w_up, w_down, ln2_g, ln2_b):
    B, S, D = x.shape
    f32 = jnp.float32
    for l in range(DEPTH):
        lambda_init = 0.8 - 0.6 * math.exp(-0.3 * l)
        lam = (jnp.exp(jnp.sum(lambda_q1[l].astype(f32) * lambda_k1[l].astype(f32)))
               - jnp.exp(jnp.sum(lambda_q2[l].astype(f32) * lambda_k2[l].astype(f32)))
               + lambda_init)

        proj = x @ w_in[l]
        q = proj[..., Q_OFF:K_OFF].reshape(B, S, N_ATTN_HEADS, 2, ATTN_QK_DIM)
        k = proj[..., K_OFF:V_OFF].reshape(B, S, N_ATTN_HEADS, 2, ATTN_QK_DIM)
        v = proj[..., V_OFF:U_OFF].reshape(B, S, N_ATTN_HEADS, ATTN_V_DIM)
        sg = jax.nn.gelu(proj[..., U_OFF:GATE_OFF], approximate=False)
        sg_u, sg_v = sg[..., :SG_WIDTH], sg[..., SG_WIDTH:]
        gates = jax.nn.sigmoid(proj[..., GATE_OFF:] + b_gate[l]).reshape(B, S, N_BRANCHES, D)

        attn_out = diff_attention(q, k, v, lam, lambda_init, attn_subln_g[l])
        sg_out = spatial_gating(sg_u, sg_v, sg_ln_g[l], sg_ln_b[l], sg_w_s[l], sg_b_s[l])

        merged = (gates[:, :, 0] * (attn_out @ w_branch_attn[l])
                  + gates[:, :, 1] * (sg_out @ w_branch_sg[l]))
        x = layer_norm(DEEPNORM_ALPHA * x + merged @ w_o[l], ln1_g[l], ln1_b[l])

        h = jnp.square(jax.nn.relu(x @ w_up[l]))
        x = layer_norm(DEEPNORM_ALPHA * x + h @ w_down[l], ln2_g[l], ln2_b[l])
    return x
```

```cpp
#include <hip/hip_runtime.h>
#include <hip/hip_cooperative_groups.h>
#include <cstdio>
#include <cstdint>
namespace cg = cooperative_groups;

#ifndef MK_N_LAUNCHES
#define MK_N_LAUNCHES 1
#endif
#ifndef ATTN_NAIVE
#define ATTN_NAIVE 1
#endif
#ifndef SGU_NAIVE
#define SGU_NAIVE 1
#endif

#ifndef DBG_CUT
#define DBG_CUT -1
#endif

#ifndef DBG_ZERO
#define DBG_ZERO 0
#endif

#ifndef DBG_PLAIN
#define DBG_PLAIN 0
#endif
#ifndef DBG_SP2
#define DBG_SP2 true
#endif
#ifndef DBG_ALIGN
#define DBG_ALIGN true
#endif

#ifndef DBG_T1
#define DBG_T1 12
#endif

namespace pg8 {
#define PG8_LAS __attribute__((address_space(3)))
typedef unsigned short bf16_t;
typedef short bf16x8 __attribute__((ext_vector_type(8)));
typedef float f32x4 __attribute__((ext_vector_type(4)));
typedef unsigned u32x4 __attribute__((ext_vector_type(4)));
constexpr int BM = 256, BK = 64, HALF = 128, HTB = HALF * BK * 2  , STAGE_BYTES = 8 * HTB, NXCD = 8, WGM = 8;

__host__ __device__ __forceinline__ int lds_byte(int r, int c) { const int st = (r >> 4) * 2 + (c >> 5), rr = r & 15, cc = c & 31, ob = rr * 64 + cc * 2; return st * 1024 + (ob ^ (((ob >> 9) & 1) << 5)); }
__host__ __device__ __forceinline__ void stage_rc(int b, int& R, int& C) { const int st = b / 1024, sb = b % 1024, swz = sb ^ (((sb >> 9) & 1) << 5); R = (st >> 1) * 16 + swz / 64; C = (st & 1) * 32 + (swz % 64) / 2; }
__host__ __device__ __forceinline__ int perm32(int rho) { const int n = rho >> 4, i = rho & 15; return 8 * (i >> 2) + 4 * n + (i & 3); }

struct Unit { int pm, pn, part; };
struct Gemm { const bf16_t* A; const bf16_t* Bt; const bf16_t* A1; const bf16_t* Bt1; int M, N, K; };

struct StaticOrder {
    int nM, nN, nwg, G, c;
    __host__ __device__ void init(int M, int N, int G_, int c_) { nM = M / BM; nN = N / BM; nwg = nM * nN; G = G_; c = c_; }
    __host__ __device__ bool next(int i, Unit& u) const {
        const long L = (long)i * G + c; if (L >= nwg) return false;
        int wgid = (int)L; { const int q = nwg / NXCD, r = nwg % NXCD, xcd = wgid % NXCD, off = wgid / NXCD; wgid = (xcd < r ? xcd * (q + 1) : r * (q + 1) + (xcd - r) * q) + off; }
        const int nig = WGM * nN, gid = wgid / nig, fm = gid * WGM, gsz = (nM - fm) < WGM ? (nM - fm) : WGM;
        u.pm = fm + ((wgid % nig) % gsz); u.pn = (wgid % nig) / gsz; u.part = 0; return true;
    }
    __device__ __forceinline__ void a_ready(const Unit&) const {}
    __device__ __forceinline__ void done(const Unit&) const {}
};

typedef float f32x2_cv __attribute__((ext_vector_type(2))); typedef __bf16 bf16x2_cv __attribute__((ext_vector_type(2)));
__device__ __forceinline__ unsigned cvt_pk_bf16(float lo, float hi) { f32x2_cv v = {lo, hi}; bf16x2_cv b = __builtin_convertvector(v, bf16x2_cv); return __builtin_bit_cast(unsigned, b); }
typedef float f32x2 __attribute__((ext_vector_type(2)));
__device__ __forceinline__ f32x2 gelu_pk(f32x2 v) {
    const f32x2 av = __builtin_elementwise_abs(v), d = av * 0.2316418882f + 1.0f;
    f32x2 t; t.x = __builtin_amdgcn_rcpf(d.x); t.y = __builtin_amdgcn_rcpf(d.y);
    f32x2 q = t * 0.5307027145f + (-0.7265760135f); q = q * t + 0.7107068705f; q = q * t + (-0.142248368f); q = q * t + 0.127414796f; q = q * t;
    const f32x2 s = (v * v) * (-0.72134752044f);
    f32x2 e; e.x = __builtin_amdgcn_exp2f(s.x); e.y = __builtin_amdgcn_exp2f(s.y);
    const f32x2 m = v * (q * e), r = v - m;
    f32x2 o; o.x = v.x < 0.f ? m.x : r.x; o.y = v.y < 0.f ? m.y : r.y; return o;
}

constexpr float kC2 = 0.125f * 1.4426950408889634f;
__device__ __forceinline__ float bf_lo(unsigned w) { return __uint_as_float(w << 16); }
__device__ __forceinline__ float bf_hi(unsigned w) { return __uint_as_float(w & 0xffff0000u); }
__device__ __forceinline__ float sigmoidf_(float z) { return __builtin_amdgcn_rcpf(1.0f + __builtin_amdgcn_exp2f(z * -1.4426950408889634f)); }

struct TwoPartOrder {
    StaticOrder so;
    __host__ __device__ void init(int M, int N, int G_, int c_) { so.init(M, N, G_, c_); }
    __host__ __device__ bool next(int i, Unit& u) const { if (!so.next(i >> 1, u)) return false; u.part = i & 1; return true; }
    __device__ __forceinline__ void a_ready(const Unit&) const {}
    __device__ __forceinline__ void done(const Unit&) const {}
};

struct EpiInProj {
    static constexpr bool PERM = true, AFTER_DRAIN = false;
    bf16_t* qkvuv;
    bf16_t* gates;
    const float* b_gate;
    float* lnpart;
    __device__ __forceinline__ void operator()(const f32x4 (&acc)[2][2][4][2], const Unit& u, int wr, int wc, int fr, int fq) const {
        const int row0 = u.pm * BM + wr * 64 + fr; const int pn = u.pn;
#if DBG_PLAIN
        {
            const int t = pn >> 2;
            bf16_t* base = (pn < 20) ? qkvuv + (size_t)t * ((size_t)16384 * 1024) + (pn & 3) * 256 + wc * 32 + 8 * fq : gates + (pn - 20) * 256 + wc * 32 + 8 * fq;
            const size_t ld = (pn < 20) ? 1024 : 4096;
#pragma unroll
            for (int ai = 0; ai < 2; ++ai)
#pragma unroll
                for (int m = 0; m < 4; ++m) { bf16_t* rowp = base + (size_t)(row0 + ai * HALF + m * 16) * ld;
#pragma unroll
                    for (int bj = 0; bj < 2; ++bj) { const f32x4 v0 = acc[ai][bj][m][0] * 0.5f, v1 = acc[ai][bj][m][1] * 0.5f;
                        u32x4 w; w.x = cvt_pk_bf16(v0[0], v0[1]); w.y = cvt_pk_bf16(v0[2], v0[3]); w.z = cvt_pk_bf16(v1[0], v1[1]); w.w = cvt_pk_bf16(v1[2], v1[3]);
                        *(u32x4*)(rowp + bj * HALF) = w; } }
            return;
        }
#endif
        if (pn < DBG_T1) {
            const int t = pn >> 2; const float sc = (t == 0) ? kC2 : 1.0f;
            bf16_t* base = qkvuv + (size_t)t * ((size_t)16384 * 1024) + (pn & 3) * 256 + wc * 32 + 8 * fq;
#pragma unroll
            for (int ai = 0; ai < 2; ++ai)
#pragma unroll
                for (int m = 0; m < 4; ++m) { bf16_t* rowp = base + (size_t)(row0 + ai * HALF + m * 16) * 1024;
#pragma unroll
                    for (int bj = 0; bj < 2; ++bj) { const f32x4 v0 = acc[ai][bj][m][0] * sc, v1 = acc[ai][bj][m][1] * sc;
                        u32x4 w; w.x = cvt_pk_bf16(v0[0], v0[1]); w.y = cvt_pk_bf16(v0[2], v0[3]); w.z = cvt_pk_bf16(v1[0], v1[1]); w.w = cvt_pk_bf16(v1[2], v1[3]);
                        *(u32x4*)(rowp + bj * HALF) = w; } }
        } else if (pn < 20) {
            const int t = pn >> 2; const bool stats = (t == 4);
            bf16_t* base = qkvuv + (size_t)t * ((size_t)16384 * 1024) + (pn & 3) * 256 + wc * 32 + 8 * fq;
#pragma unroll
            for (int ai = 0; ai < 2; ++ai)
#pragma unroll
                for (int m = 0; m < 4; ++m) { const int row = row0 + ai * HALF + m * 16; bf16_t* rowp = base + (size_t)row * 1024; float s1 = 0.f, s2 = 0.f;
#pragma unroll
                    for (int bj = 0; bj < 2; ++bj) { const f32x4 x0 = acc[ai][bj][m][0], x1 = acc[ai][bj][m][1];
                        const f32x2 a = gelu_pk((f32x2){x0[0], x0[1]}), b = gelu_pk((f32x2){x0[2], x0[3]}), c = gelu_pk((f32x2){x1[0], x1[1]}), d = gelu_pk((f32x2){x1[2], x1[3]});
                        s1 += ((a.x + a.y) + (b.x + b.y)) + ((c.x + c.y) + (d.x + d.y));
                        s2 += ((a.x * a.x + a.y * a.y) + (b.x * b.x + b.y * b.y)) + ((c.x * c.x + c.y * c.y) + (d.x * d.x + d.y * d.y));
                        u32x4 w; w.x = cvt_pk_bf16(a.x, a.y); w.y = cvt_pk_bf16(b.x, b.y); w.z = cvt_pk_bf16(c.x, c.y); w.w = cvt_pk_bf16(d.x, d.y);
                        *(u32x4*)(rowp + bj * HALF) = w; }
                    if (stats) { s1 += __shfl_xor(s1, 16); s1 += __shfl_xor(s1, 32); s2 += __shfl_xor(s2, 16); s2 += __shfl_xor(s2, 32);
                        if (fq == 0) *(f32x2*)(lnpart + ((size_t)row * 16 + (pn - 16) * 4 + wc) * 2) = (f32x2){s1, s2}; } }
        } else {
            const int colg = (pn - 20) * 256 + wc * 32 + 8 * fq;
            f32x4 bv[2][2];
#pragma unroll
            for (int bj = 0; bj < 2; ++bj)
#pragma unroll
                for (int n = 0; n < 2; ++n) bv[bj][n] = *(const f32x4*)(b_gate + colg + bj * HALF + 4 * n);
#pragma unroll
            for (int ai = 0; ai < 2; ++ai)
#pragma unroll
                for (int m = 0; m < 4; ++m) { bf16_t* rowp = gates + (size_t)(row0 + ai * HALF + m * 16) * 4096 + colg;
#pragma unroll
                    for (int bj = 0; bj < 2; ++bj) { const f32x4 z0 = acc[ai][bj][m][0] + bv[bj][0], z1 = acc[ai][bj][m][1] + bv[bj][1];
                        u32x4 w; w.x = cvt_pk_bf16(sigmoidf_(z0[0]), sigmoidf_(z0[1])); w.y = cvt_pk_bf16(sigmoidf_(z0[2]), sigmoidf_(z0[3]));
                        w.z = cvt_pk_bf16(sigmoidf_(z1[0]), sigmoidf_(z1[1])); w.w = cvt_pk_bf16(sigmoidf_(z1[2]), sigmoidf_(z1[3]));
                        *(u32x4*)(rowp + bj * HALF) = w; } }
        }
    }
};

struct EpiMerge {
    static constexpr bool PERM = false, AFTER_DRAIN = false;
    const bf16_t* gates; float* tmp; bf16_t* merged;
    __device__ __forceinline__ void operator()(const f32x4 (&acc)[2][2][4][2], const Unit& u, int wr, int wc, int fr, int fq) const {
        typedef unsigned u32x2v __attribute__((ext_vector_type(2)));
        const int row0 = u.pm * BM + wr * 64 + fr, col0 = u.pn * BM + wc * 32 + 4 * fq; const int part = u.part;
#pragma unroll
        for (int ai = 0; ai < 2; ++ai)
#pragma unroll
            for (int m = 0; m < 4; ++m) { const size_t r = (size_t)(row0 + ai * HALF + m * 16);
#pragma unroll
                for (int bj = 0; bj < 2; ++bj)
#pragma unroll
                    for (int n = 0; n < 2; ++n) { const int c = col0 + bj * HALF + n * 16;
                        const u32x2v gw = *(const u32x2v*)(gates + r * 4096 + part * 2048 + c);
                        const f32x4 g = (f32x4){bf_lo(gw.x), bf_hi(gw.x), bf_lo(gw.y), bf_hi(gw.y)};
                        const f32x4 v = g * acc[ai][bj][m][n];
                        if (part == 0) { *(f32x4*)(tmp + r * 2048 + c) = v; }
                        else { const f32x4 o = *(const f32x4*)(tmp + r * 2048 + c) + v; u32x2v w; w.x = cvt_pk_bf16(o[0], o[1]); w.y = cvt_pk_bf16(o[2], o[3]); *(u32x2v*)(merged + r * 2048 + c) = w; } } }
        if (part == 0) asm volatile("s_waitcnt vmcnt(0)" ::: "memory");
    }
};

struct EpiResid {
    static constexpr bool PERM = false, AFTER_DRAIN = false;
    const float* base; float* out; float alpha;
    __device__ __forceinline__ void operator()(const f32x4 (&acc)[2][2][4][2], const Unit& u, int wr, int wc, int fr, int fq) const {
        const int row0 = u.pm * BM + wr * 64 + fr, col0 = u.pn * BM + wc * 32 + 4 * fq;
#pragma unroll
        for (int ai = 0; ai < 2; ++ai)
#pragma unroll
            for (int m = 0; m < 4; ++m) { const size_t r = (size_t)(row0 + ai * HALF + m * 16);
#pragma unroll
                for (int bj = 0; bj < 2; ++bj)
#pragma unroll
                    for (int n = 0; n < 2; ++n) { const size_t off = r * 2048 + col0 + bj * HALF + n * 16;
                        const f32x4 b = *(const f32x4*)(base + off); *(f32x4*)(out + off) = b * alpha + acc[ai][bj][m][n]; } }
    }
};

struct EpiRelu2 {
    static constexpr bool PERM = true, AFTER_DRAIN = false;
    bf16_t* H;
    __device__ __forceinline__ void operator()(const f32x4 (&acc)[2][2][4][2], const Unit& u, int wr, int wc, int fr, int fq) const {
        const int row0 = u.pm * BM + wr * 64 + fr, col0 = u.pn * BM + wc * 32 + 8 * fq;
#pragma unroll
        for (int ai = 0; ai < 2; ++ai)
#pragma unroll
            for (int m = 0; m < 4; ++m) { bf16_t* rowp = H + (size_t)(row0 + ai * HALF + m * 16) * 8192 + col0;
#pragma unroll
                for (int bj = 0; bj < 2; ++bj) { f32x4 v0 = acc[ai][bj][m][0], v1 = acc[ai][bj][m][1];
#pragma unroll
                    for (int e = 0; e < 4; ++e) { const float a = fmaxf(v0[e], 0.f), b = fmaxf(v1[e], 0.f); v0[e] = a * a; v1[e] = b * b; }
                    u32x4 w; w.x = cvt_pk_bf16(v0[0], v0[1]); w.y = cvt_pk_bf16(v0[2], v0[3]); w.z = cvt_pk_bf16(v1[0], v1[1]); w.w = cvt_pk_bf16(v1[2], v1[3]);
                    *(u32x4*)(rowp + bj * HALF) = w; } }
    }
};

template <class Epi, class Sched, bool ALIGN_EPI = false, bool SP2 = false>
__device__ __forceinline__ void gemm_phase(PG8_LAS unsigned char* lds, const Gemm g, const Sched& S, const Epi& E) {
    const int tid = threadIdx.x, wid = __builtin_amdgcn_readfirstlane(tid >> 6), lane = tid & 63, wr = wid >> 2, wc = wid & 3, fr = lane & 15, fq = lane >> 4;
    const int K = g.K, nt = K / BK;
    unsigned voffA[2], voffB[2];
#pragma unroll
    for (int i = 0; i < 2; ++i) { int R, C; stage_rc(tid * 16 + i * 8192, R, C); const int Rb = Epi::PERM ? ((R & ~31) + perm32(R & 31)) : R;
        voffA[i] = (unsigned)(R * K + C) * 2u; voffB[i] = (unsigned)(Rb * K + C) * 2u; }
    const size_t kstep = (size_t)(BK * 2);
    const size_t hstep = (size_t)HALF * K * 2;
    const size_t tstep = 2 * hstep;
    const unsigned ldsw = (unsigned)wid * 1024u;
    const int aoff = lds_byte(wr * 64 + fr, fq * 8), boff = lds_byte(wc * 32 + fr, fq * 8);
#define PG8_SA(b, h) (((b) * 2 + (h)) * HTB)
#define PG8_SB(b, h) ((4 + (b) * 2 + (h)) * HTB)
#define PG8_STAGE(bufoff, gbase, voff) do { _Pragma("unroll") for (int _i = 0; _i < 2; ++_i) \
        __builtin_amdgcn_global_load_lds((const unsigned*)((const char*)(gbase) + (voff)[_i]), (PG8_LAS unsigned*)(lds + (bufoff) + ldsw + _i * 8192), 16, 0, 0); } while (0)
#define PG8_LDA(dst, b, h) do { _Pragma("unroll") for (int m = 0; m < 4; ++m) _Pragma("unroll") for (int k = 0; k < 2; ++k) dst[m][k] = *(const PG8_LAS bf16x8*)(lds + PG8_SA(b, h) + aoff + m * 2048 + k * 1024); } while (0)
#define PG8_LDB(dst, b, h) do { _Pragma("unroll") for (int n = 0; n < 2; ++n) _Pragma("unroll") for (int k = 0; k < 2; ++k) dst[n][k] = *(const PG8_LAS bf16x8*)(lds + PG8_SB(b, h) + boff + n * 2048 + k * 1024); } while (0)
#define PG8_MMA(ai, bj, At, Bt) do { __builtin_amdgcn_s_setprio(1); _Pragma("unroll") for (int m = 0; m < 4; ++m) _Pragma("unroll") for (int n = 0; n < 2; ++n) _Pragma("unroll") for (int k = 0; k < 2; ++k) \
        acc[ai][bj][m][n] = __builtin_amdgcn_mfma_f32_16x16x32_bf16(Bt[n][k], At[m][k], acc[ai][bj][m][n], 0, 0, 0); __builtin_amdgcn_s_setprio(0); } while (0)
#define PG8_WAIT_V(n) asm volatile("s_waitcnt vmcnt(" #n ")" ::: "memory")
#define PG8_WAIT_L(n) asm volatile("s_waitcnt lgkmcnt(" #n ")" ::: "memory")
#define PG8_BAR __builtin_amdgcn_s_barrier()
#define PG8_SCHED __builtin_amdgcn_sched_barrier(0)
    Unit cur, nxt; int ui = 0;
    if (!S.next(0, cur)) return;
    f32x4 acc[2][2][4][2];
#pragma unroll
    for (int a = 0; a < 2; ++a)
#pragma unroll
        for (int b = 0; b < 2; ++b)
#pragma unroll
            for (int m = 0; m < 4; ++m)
#pragma unroll
                for (int n = 0; n < 2; ++n) acc[a][b][m][n] = (f32x4){0.f, 0.f, 0.f, 0.f};
    bf16x8 At[4][2], B0[2][2], B1[2][2];
    const char* cA = (const char*)(cur.part ? g.A1 : g.A) + (size_t)cur.pm * tstep; const char* cB = (const char*)(cur.part ? g.Bt1 : g.Bt) + (size_t)cur.pn * tstep;
    S.a_ready(cur);
    if constexpr (SP2) {
        PG8_STAGE(PG8_SB(0, 0), cB, voffB); PG8_STAGE(PG8_SB(0, 1), cB + hstep, voffB); PG8_STAGE(PG8_SA(0, 0), cA, voffA); PG8_STAGE(PG8_SA(0, 1), cA + hstep, voffA);
        if (wr == 1) PG8_BAR;
        PG8_WAIT_V(2); PG8_BAR;
        PG8_STAGE(PG8_SB(1, 0), cB + kstep, voffB); PG8_STAGE(PG8_SA(1, 0), cA + kstep, voffA); PG8_STAGE(PG8_SB(1, 1), cB + hstep + kstep, voffB);
        PG8_WAIT_V(6); PG8_BAR;
    } else {
        PG8_STAGE(PG8_SB(0, 0), cB, voffB); PG8_STAGE(PG8_SA(0, 0), cA, voffA); PG8_STAGE(PG8_SB(0, 1), cB + hstep, voffB); PG8_STAGE(PG8_SA(0, 1), cA + hstep, voffA);
        if (wr == 1) PG8_BAR;
        PG8_WAIT_V(4); PG8_BAR;
        PG8_STAGE(PG8_SB(1, 0), cB + kstep, voffB); PG8_STAGE(PG8_SA(1, 0), cA + kstep, voffA); PG8_STAGE(PG8_SB(1, 1), cB + hstep + kstep, voffB);
        PG8_WAIT_V(6); PG8_BAR;
    }
    for (;;) {
        const bool has_next = S.next(ui + 1, nxt);
        const char* nA = has_next ? (const char*)(nxt.part ? g.A1 : g.A) + (size_t)nxt.pm * tstep : cA; const char* nB = has_next ? (const char*)(nxt.part ? g.Bt1 : g.Bt) + (size_t)nxt.pn * tstep : cB;
        for (int t = 0; t < nt; t += 2) {
            const bool last = (t == nt - 2);
            const char* a1 = cA + (size_t)(t + 1) * kstep;
            const char* a2 = last ? nA : cA + (size_t)(t + 2) * kstep; const char* b2 = last ? nB : cB + (size_t)(t + 2) * kstep;
            const char* a3 = a2 + kstep; const char* b3 = b2 + kstep;
            if (last && has_next) S.a_ready(nxt);
            if constexpr (SP2) {
            PG8_LDB(B0, 0, 0); PG8_LDB(B1, 0, 1); PG8_SCHED; PG8_LDA(At, 0, 0); PG8_STAGE(PG8_SA(1, 1), a1 + hstep, voffA);
            PG8_WAIT_V(8); PG8_WAIT_L(0); PG8_BAR; PG8_MMA(0, 0, At, B0); PG8_MMA(0, 1, At, B1); PG8_BAR; PG8_SCHED;
            PG8_LDA(At, 0, 1); PG8_STAGE(PG8_SB(0, 0), b2, voffB); PG8_STAGE(PG8_SB(0, 1), b2 + hstep, voffB); PG8_STAGE(PG8_SA(0, 0), a2, voffA);
            PG8_WAIT_V(8); PG8_WAIT_L(0); PG8_BAR; PG8_MMA(1, 0, At, B0); PG8_MMA(1, 1, At, B1); PG8_BAR; PG8_SCHED;
            PG8_LDB(B0, 1, 0); PG8_LDB(B1, 1, 1); PG8_SCHED; PG8_LDA(At, 1, 0); PG8_STAGE(PG8_SA(0, 1), a2 + hstep, voffA);
            PG8_WAIT_V(8); PG8_WAIT_L(0); PG8_BAR; PG8_MMA(0, 0, At, B0); PG8_MMA(0, 1, At, B1); PG8_BAR; PG8_SCHED;
            PG8_LDA(At, 1, 1); PG8_STAGE(PG8_SB(1, 0), b3, voffB); PG8_STAGE(PG8_SB(1, 1), b3 + hstep, voffB); PG8_STAGE(PG8_SA(1, 0), a3, voffA);
            PG8_WAIT_V(8); PG8_WAIT_L(0); PG8_BAR; PG8_MMA(1, 0, At, B0); PG8_MMA(1, 1, At, B1); PG8_BAR; PG8_SCHED;
            } else {
            PG8_LDB(B0, 0, 0); PG8_SCHED; PG8_LDA(At, 0, 0); PG8_STAGE(PG8_SA(1, 1), a1 + hstep, voffA);
            PG8_WAIT_L(8); PG8_BAR; PG8_WAIT_L(0); PG8_MMA(0, 0, At, B0); PG8_BAR; PG8_SCHED;
            PG8_LDB(B1, 0, 1); PG8_STAGE(PG8_SB(0, 0), b2, voffB);
            PG8_BAR; PG8_WAIT_L(0); PG8_MMA(0, 1, At, B1); PG8_BAR;
            PG8_LDA(At, 0, 1); PG8_STAGE(PG8_SA(0, 0), a2, voffA);
            PG8_BAR; PG8_WAIT_L(0); PG8_MMA(1, 0, At, B0); PG8_BAR; PG8_SCHED;
            PG8_STAGE(PG8_SB(0, 1), b2 + hstep, voffB);
            PG8_WAIT_V(6); PG8_BAR; PG8_MMA(1, 1, At, B1); PG8_BAR;
            PG8_LDB(B0, 1, 0); PG8_SCHED; PG8_LDA(At, 1, 0); PG8_STAGE(PG8_SA(0, 1), a2 + hstep, voffA);
            PG8_WAIT_L(8); PG8_BAR; PG8_WAIT_L(0); PG8_MMA(0, 0, At, B0); PG8_BAR; PG8_SCHED;
            PG8_LDB(B1, 1, 1); PG8_STAGE(PG8_SB(1, 0), b3, voffB);
            PG8_BAR; PG8_WAIT_L(0); PG8_MMA(0, 1, At, B1); PG8_BAR;
            PG8_LDA(At, 1, 1); PG8_STAGE(PG8_SA(1, 0), a3, voffA);
            PG8_BAR; PG8_WAIT_L(0); PG8_MMA(1, 0, At, B0); PG8_BAR; PG8_SCHED;
            PG8_STAGE(PG8_SB(1, 1), b3 + hstep, voffB);
            PG8_WAIT_V(6); PG8_BAR; PG8_MMA(1, 1, At, B1); PG8_BAR;
            }
        }
        if constexpr (ALIGN_EPI) { if (wr == 0) PG8_BAR; }
        if constexpr (!Epi::AFTER_DRAIN) { E(acc, cur, wr, wc, fr, fq); S.done(cur); }
        if (!has_next) break;
#pragma unroll
        for (int a = 0; a < 2; ++a)
#pragma unroll
            for (int b = 0; b < 2; ++b)
#pragma unroll
                for (int m = 0; m < 4; ++m)
#pragma unroll
                    for (int n = 0; n < 2; ++n) acc[a][b][m][n] = (f32x4){0.f, 0.f, 0.f, 0.f};
        cur = nxt; cA = nA; cB = nB; ++ui;
        if constexpr (ALIGN_EPI) { if (wr == 1) PG8_BAR; }
    }
    PG8_WAIT_V(0);
    if constexpr (!ALIGN_EPI) { if (wr == 0) PG8_BAR; }
    PG8_BAR;
    if constexpr (Epi::AFTER_DRAIN) { E.fused(acc, cur, wr, wc, fr, fq, lds, wid, lane); S.done(cur); }
#undef PG8_SA
#undef PG8_SB
#undef PG8_STAGE
#undef PG8_LDA
#undef PG8_LDB
#undef PG8_MMA
#undef PG8_WAIT_V
#undef PG8_WAIT_L
#undef PG8_BAR
#undef PG8_SCHED
}
}

#define GAS __attribute__((address_space(1)))
#define LAS __attribute__((address_space(3)))
typedef unsigned short bf16;
typedef unsigned v4u __attribute__((ext_vector_type(4)));
typedef unsigned v2u __attribute__((ext_vector_type(2)));
typedef float f32x4 __attribute__((ext_vector_type(4)));
typedef float f32x2 __attribute__((ext_vector_type(2)));
typedef short bf16x8 __attribute__((ext_vector_type(8)));

constexpr int NB = 4, SEQ = 4096, NTOK = NB * SEQ, DM = 2048, INW = 9216, NH = 8, QKW = 1024, SGW = 1024, DFF = 8192;
constexpr float LN_EPS = 1e-5f;
constexpr float DN_ALPHA = 1.189207115002721f;
constexpr float LAMBDA_INIT = 0.2f;
constexpr int NWAVES = 8;

constexpr size_t MiB = 1u << 20;
constexpr size_t WS_CTL = 0, CTL_ZERO_BYTES = 1 * MiB;
constexpr size_t WS_LNPART = 2 * MiB;
constexpr size_t WS_WIN = 4 * MiB;
constexpr size_t WS_WBA = 40 * MiB;
constexpr size_t WS_WBS = 44 * MiB;
constexpr size_t WS_WO = 48 * MiB;
constexpr size_t WS_WUP = 56 * MiB;
constexpr size_t WS_WDN = 88 * MiB;
constexpr size_t WS_XB = 120 * MiB;
constexpr size_t WS_Q = 184 * MiB, WS_K = 216 * MiB, WS_V = 248 * MiB, WS_U = 280 * MiB, WS_SV = 312 * MiB;
constexpr size_t WS_GATES = 344 * MiB;
constexpr size_t WS_MERGED = WS_K;
constexpr size_t WS_H = WS_Q;
constexpr size_t WS_END = 472 * MiB;
static_assert(WS_H + (size_t)NTOK * DFF * 2 <= WS_END && WS_GATES + (size_t)NTOK * 4096 * 2 == WS_END, "d_ws map");

constexpr int LDS_BYTES = 147456;

__device__ __forceinline__ unsigned f2bf(float f) { unsigned u = __builtin_bit_cast(unsigned, f); return (u + 0x7fffu + ((u >> 16) & 1u)) >> 16; }
__device__ __forceinline__ unsigned pk2(float lo, float hi) { return f2bf(lo) | (f2bf(hi) << 16); }
__device__ __forceinline__ float bflo(unsigned w) { return __uint_as_float(w << 16); }
__device__ __forceinline__ float bfhi(unsigned w) { return __uint_as_float(w & 0xffff0000u); }
#define LDS_WAIT() asm volatile("s_waitcnt lgkmcnt(0)" ::: "memory")

struct Frame {
    LAS unsigned char* lds;
    int tid, lane, wave, vcu, G;
};

__device__ __forceinline__ float wave_sum(float v) {
#pragma unroll
    for (int o = 1; o < 64; o <<= 1) v += __shfl_xor(v, o);
    return v;
}

__device__ __forceinline__ void p0_transpose_item(const float* W, int K, int N, bf16* WT, LAS float* scr, int item, int lane) {
    const int nblk = N / 32, kb = item / nblk, nb = item % nblk, k0 = 64 * kb, n0 = 32 * nb;
#pragma unroll 8
    for (int i = 0; i < 32; ++i) { const int kk = 2 * i + (lane >> 5); scr[kk * 33 + (lane & 31)] = W[(size_t)(k0 + kk) * N + n0 + (lane & 31)]; }
    LDS_WAIT(); asm volatile("" ::: "memory");
    const int c = lane & 7;
#pragma unroll
    for (int j = 0; j < 4; ++j) { const int n = (lane >> 3) + 8 * j; const LAS float* s = scr + (8 * c) * 33 + n;
        v4u o; o.x = pk2(s[0 * 33], s[1 * 33]); o.y = pk2(s[2 * 33], s[3 * 33]); o.z = pk2(s[4 * 33], s[5 * 33]); o.w = pk2(s[6 * 33], s[7 * 33]);
        *(GAS v4u*)(WT + (size_t)(n0 + n) * K + k0 + 8 * c) = o; }
    LDS_WAIT(); asm volatile("" ::: "memory");
}

struct P0Args { const float *x, *w_in, *w_ba, *w_bs, *w_o, *w_up, *w_dn; bf16 *xb, *win_t, *wba_t, *wbs_t, *wo_t, *wup_t, *wdn_t; };
__device__ __forceinline__ void p0_prologue(const Frame& F, const P0Args& A) {
    LAS float* scr = (LAS float*)(F.lds + F.wave * 16384);
    const int gw = F.vcu * NWAVES + F.wave, NGW = F.G * NWAVES;
    constexpr int I_IN = (DM / 64) * (INW / 32), I_BA = (1024 / 64) * (DM / 32), I_O = (DM / 64) * (DM / 32), I_UP = (DM / 64) * (DFF / 32), I_DN = (DFF / 64) * (DM / 32);
    constexpr int NITEMS = I_IN + 2 * I_BA + I_O + I_UP + I_DN;
    for (int it = gw; it < NITEMS; it += NGW) {
        int r = it;
        if (r < I_IN) { p0_transpose_item(A.w_in, DM, INW, A.win_t, scr, r, F.lane); continue; } r -= I_IN;
        if (r < I_BA) { p0_transpose_item(A.w_ba, 1024, DM, A.wba_t, scr, r, F.lane); continue; } r -= I_BA;
        if (r < I_BA) { p0_transpose_item(A.w_bs, 1024, DM, A.wbs_t, scr, r, F.lane); continue; } r -= I_BA;
        if (r < I_O) { p0_transpose_item(A.w_o, DM, DM, A.wo_t, scr, r, F.lane); continue; } r -= I_O;
        if (r < I_UP) { p0_transpose_item(A.w_up, DM, DFF, A.wup_t, scr, r, F.lane); continue; } r -= I_UP;
        p0_transpose_item(A.w_dn, DFF, DM, A.wdn_t, scr, r, F.lane);
    }
    const size_t n8 = (size_t)NTOK * DM / 8, nthr = (size_t)F.G * 512;
    for (size_t i = (size_t)F.vcu * 512 + F.tid; i < n8; i += nthr) {
        const f32x4 a = *(const GAS f32x4*)(A.x + i * 8), b = *(const GAS f32x4*)(A.x + i * 8 + 4);
        v4u o; o.x = pk2(a.x, a.y); o.y = pk2(a.z, a.w); o.z = pk2(b.x, b.y); o.w = pk2(b.z, b.w);
        *(GAS v4u*)(A.xb + i * 8) = o;
    }
}

__device__ __forceinline__ void ln_rows(const Frame& F, const float* in, float* outf, bf16* outb, const float* g, const float* b) {
    const int gw = F.vcu * NWAVES + F.wave, NGW = F.G * NWAVES;
    for (int m = gw; m < NTOK; m += NGW) {
        const GAS f32x4* xr = (const GAS f32x4*)(in + (size_t)m * DM) + F.lane;
        f32x4 v[8]; float s = 0.f;
#pragma unroll
        for (int j = 0; j < 8; ++j) { v[j] = xr[64 * j]; s += (v[j].x + v[j].y) + (v[j].z + v[j].w); }
        const float mean = wave_sum(s) * (1.f / DM); float s2 = 0.f;
#pragma unroll
        for (int j = 0; j < 8; ++j) { v[j] = v[j] - mean; s2 += (v[j].x * v[j].x + v[j].y * v[j].y) + (v[j].z * v[j].z + v[j].w * v[j].w); }
        const float rstd = 1.0f / sqrtf(wave_sum(s2) * (1.f / DM) + LN_EPS);
#pragma unroll
        for (int j = 0; j < 8; ++j) {
            const f32x4 gg = *((const GAS f32x4*)g + F.lane + 64 * j), bb = *((const GAS f32x4*)b + F.lane + 64 * j);
            const f32x4 y = v[j] * rstd * gg + bb;
            if (outf) *((GAS f32x4*)(outf + (size_t)m * DM) + F.lane + 64 * j) = y;
            if (outb) { v2u w; w.x = pk2(y.x, y.y); w.y = pk2(y.z, y.w); *((GAS v2u*)(outb + (size_t)m * DM) + F.lane + 64 * j) = w; }
        }
    }
}

__device__ __forceinline__ float compute_lam(const float* lq1, const float* lk1, const float* lq2, const float* lk2, int lane) {
    const float a = wave_sum(lq1[lane] * lk1[lane]), b = wave_sum(lq2[lane] * lk2[lane]);
    return expf(a) - expf(b) + LAMBDA_INIT;
}

struct SguArgs { const bf16* sv; bf16* u; const float* lnpart; const float *ln_g, *ln_b, *w_s, *b_s; };
__device__ __forceinline__ void sgu_unit_naive(const Frame& F, const SguArgs& A, int c, int g) {
    LAS float* vn = (LAS float*)F.lds;
    const int tid = F.tid, s = tid >> 2, dq = (tid & 3) * 32; const size_t row = (size_t)c * 128 + s;
    {
        float s1 = 0.f, s2 = 0.f;
#pragma unroll
        for (int p = 0; p < 16; ++p) { const f32x2 t = *(const GAS f32x2*)(A.lnpart + (row * 16 + p) * 2); s1 += t.x; s2 += t.y; }
        const float mean = s1 * (1.f / SGW), var = fmaxf(s2 * (1.f / SGW) - mean * mean, 0.f), rstd = 1.0f / sqrtf(var + LN_EPS);
        const GAS v4u* src = (const GAS v4u*)(A.sv + row * SGW + g * 128 + dq);
#pragma unroll
        for (int q = 0; q < 4; ++q) { const v4u w = src[q]; const int d0 = dq + 8 * q; const int ch = g * 128 + d0;
            float x[8] = {bflo(w.x), bfhi(w.x), bflo(w.y), bfhi(w.y), bflo(w.z), bfhi(w.z), bflo(w.w), bfhi(w.w)};
#pragma unroll
            for (int e = 0; e < 8; ++e) vn[s * 128 + d0 + e] = (x[e] - mean) * rstd * A.ln_g[ch + e] + A.ln_b[ch + e]; }
    }
    __syncthreads();
    const int t = s; float acc[32];
#pragma unroll
    for (int e = 0; e < 32; ++e) acc[e] = 0.f;
    const float* wrow = A.w_s + ((size_t)g * 128 + t) * 128;
    for (int ss = 0; ss < 128; ++ss) { const float w = wrow[ss]; const LAS f32x4* vr = (const LAS f32x4*)(vn + ss * 128 + dq);
#pragma unroll
        for (int q = 0; q < 8; ++q) { const f32x4 v = vr[q]; acc[4 * q] += w * v.x; acc[4 * q + 1] += w * v.y; acc[4 * q + 2] += w * v.z; acc[4 * q + 3] += w * v.w; } }
    const float bs = A.b_s[g * 128 + t];
    GAS v4u* up = (GAS v4u*)(A.u + row * SGW + g * 128 + dq);
#pragma unroll
    for (int q = 0; q < 4; ++q) { const v4u w = up[q]; v4u o;
        o.x = pk2(bflo(w.x) * (acc[8 * q + 0] + bs), bfhi(w.x) * (acc[8 * q + 1] + bs)); o.y = pk2(bflo(w.y) * (acc[8 * q + 2] + bs), bfhi(w.y) * (acc[8 * q + 3] + bs));
        o.z = pk2(bflo(w.z) * (acc[8 * q + 4] + bs), bfhi(w.z) * (acc[8 * q + 5] + bs)); o.w = pk2(bflo(w.w) * (acc[8 * q + 6] + bs), bfhi(w.w) * (acc[8 * q + 7] + bs));
        up[q] = o; }
    __syncthreads();
}

struct AttnArgs { const bf16* q; const bf16* k; const bf16* v; bf16* o; const float* gain; float lam; };
__device__ __forceinline__ void attn_unit_naive(const Frame& F, const AttnArgs& A, int b, int h, int qb) {
    LAS unsigned char* lds = F.lds;
    LAS bf16* Ks = (LAS bf16*)lds; LAS bf16* Vs = (LAS bf16*)(lds + 8192);
    const int tid = F.tid, r = tid & 127, c = (tid >> 7) & 1, half = tid >> 8;
    const size_t rowbase = (size_t)b * SEQ; const int qpos = qb * 128 + r;
    float q[64];
    { const GAS v4u* qp = (const GAS v4u*)(A.q + (rowbase + qpos) * QKW + h * 128 + c * 64);
#pragma unroll
      for (int i = 0; i < 8; ++i) { const v4u w = qp[i]; q[8 * i] = bflo(w.x); q[8 * i + 1] = bfhi(w.x); q[8 * i + 2] = bflo(w.y); q[8 * i + 3] = bfhi(w.y); q[8 * i + 4] = bflo(w.z); q[8 * i + 5] = bfhi(w.z); q[8 * i + 6] = bflo(w.w); q[8 * i + 7] = bfhi(w.w); } }
    float o[64];
#pragma unroll
    for (int d = 0; d < 64; ++d) o[d] = 0.f;
    float m = -1e30f, l = 0.f;
    const float slope2 = __builtin_amdgcn_exp2f(-(float)(h + 1)) * 1.4426950408889634f;
    const int skey = tid >> 4, sch = (tid & 15) * 8;
    for (int kt = 0; kt < SEQ / 32; ++kt) {
        __syncthreads();
        { const size_t grow = (rowbase + (size_t)kt * 32 + skey) * QKW + h * 128 + sch;
          *(LAS v4u*)(Ks + skey * 128 + sch) = *(const GAS v4u*)(A.k + grow);
          *(LAS v4u*)(Vs + skey * 128 + sch) = *(const GAS v4u*)(A.v + grow); }
        __syncthreads();
        for (int j = 0; j < 32; ++j) {
            const LAS v4u* kp = (const LAS v4u*)(Ks + j * 128 + c * 64);
            float dot = 0.f;
#pragma unroll
            for (int i = 0; i < 8; ++i) { const v4u w = kp[i];
                dot += q[8 * i] * bflo(w.x) + q[8 * i + 1] * bfhi(w.x) + q[8 * i + 2] * bflo(w.y) + q[8 * i + 3] * bfhi(w.y) + q[8 * i + 4] * bflo(w.z) + q[8 * i + 5] * bfhi(w.z) + q[8 * i + 6] * bflo(w.w) + q[8 * i + 7] * bfhi(w.w); }
            const float t = dot - slope2 * fabsf((float)(qpos - (kt * 32 + j)));
            const float mn = fmaxf(m, t), al = __builtin_amdgcn_exp2f(m - mn), p = __builtin_amdgcn_exp2f(t - mn);
            l = l * al + p; m = mn;
            const LAS v4u* vp = (const LAS v4u*)(Vs + j * 128 + half * 64);
#pragma unroll
            for (int i = 0; i < 8; ++i) { const v4u w = vp[i];
                o[8 * i] = o[8 * i] * al + p * bflo(w.x); o[8 * i + 1] = o[8 * i + 1] * al + p * bfhi(w.x); o[8 * i + 2] = o[8 * i + 2] * al + p * bflo(w.y); o[8 * i + 3] = o[8 * i + 3] * al + p * bfhi(w.y);
                o[8 * i + 4] = o[8 * i + 4] * al + p * bflo(w.z); o[8 * i + 5] = o[8 * i + 5] * al + p * bfhi(w.z); o[8 * i + 6] = o[8 * i + 6] * al + p * bflo(w.w); o[8 * i + 7] = o[8 * i + 7] * al + p * bfhi(w.w); }
        }
    }
    __syncthreads();
    LAS float* Ax = (LAS float*)lds;
    { const float rl = 1.0f / l; LAS float* dst = Ax + ((size_t)c * 128 + r) * 128 + half * 64;
#pragma unroll
      for (int d = 0; d < 64; ++d) dst[d] = o[d] * rl; }
    __syncthreads();
    { const int r2 = tid >> 2, qd = (tid & 3) * 32; float x[32]; float ss = 0.f;
#pragma unroll
      for (int e = 0; e < 32; ++e) { x[e] = Ax[(size_t)r2 * 128 + qd + e] - A.lam * Ax[(size_t)(128 + r2) * 128 + qd + e]; ss += x[e] * x[e]; }
      ss += __shfl_xor(ss, 1); ss += __shfl_xor(ss, 2);
      const float rstd = 1.0f / sqrtf(ss * (1.f / 128.f) + LN_EPS) * (1.0f - LAMBDA_INIT);
      GAS v4u* op = (GAS v4u*)(A.o + (rowbase + (size_t)qb * 128 + r2) * QKW + h * 128 + qd);
#pragma unroll
      for (int i = 0; i < 4; ++i) { v4u w;
          w.x = pk2(x[8 * i] * rstd * A.gain[qd + 8 * i], x[8 * i + 1] * rstd * A.gain[qd + 8 * i + 1]); w.y = pk2(x[8 * i + 2] * rstd * A.gain[qd + 8 * i + 2], x[8 * i + 3] * rstd * A.gain[qd + 8 * i + 3]);
          w.z = pk2(x[8 * i + 4] * rstd * A.gain[qd + 8 * i + 4], x[8 * i + 5] * rstd * A.gain[qd + 8 * i + 5]); w.w = pk2(x[8 * i + 6] * rstd * A.gain[qd + 8 * i + 6], x[8 * i + 7] * rstd * A.gain[qd + 8 * i + 7]);
          op[i] = w; } }
    __syncthreads();
}

struct Args { const float* in[21]; float* out; unsigned char* ws; int ph_lo, ph_hi; };
constexpr int N_PHASES = 9;

__global__ void __launch_bounds__(NWAVES * 64, 2) fwd_kernel(Args args) {
    extern __shared__ __attribute__((aligned(16))) unsigned char lds_raw[];
    Frame F;
    F.lds = (LAS unsigned char*)lds_raw;
    F.tid = threadIdx.x; F.lane = F.tid & 63; F.wave = __builtin_amdgcn_readfirstlane(F.tid >> 6);
    F.G = gridDim.x; { const int bx = blockIdx.x; F.vcu = (F.G % 8 == 0) ? (bx % 8) * (F.G / 8) + bx / 8 : bx; }
    unsigned char* ws = args.ws;
    const float* x = args.in[0];
    bf16* XB = (bf16*)(ws + WS_XB); bf16* QB = (bf16*)(ws + WS_Q); bf16* KB = (bf16*)(ws + WS_K); bf16* VB = (bf16*)(ws + WS_V); bf16* UB = (bf16*)(ws + WS_U); bf16* SVB = (bf16*)(ws + WS_SV);
    bf16* GATES = (bf16*)(ws + WS_GATES); bf16* MERGED = (bf16*)(ws + WS_MERGED); bf16* HB = (bf16*)(ws + WS_H);
    bf16* WIN = (bf16*)(ws + WS_WIN); bf16* WBA = (bf16*)(ws + WS_WBA); bf16* WBS = (bf16*)(ws + WS_WBS); bf16* WO = (bf16*)(ws + WS_WO); bf16* WUP = (bf16*)(ws + WS_WUP); bf16* WDN = (bf16*)(ws + WS_WDN);
    float* LNPART = (float*)(ws + WS_LNPART);
    float* out = args.out;
    const int lo = args.ph_lo, hi = args.ph_hi;
#define IN(k) (lo <= (k) && (k) < hi)
#define SEAM(k) do { if (IN(k) && IN((k) + 1)) { cg::this_grid().sync(); } } while (0)

#if DBG_ZERO & 1
    for (int u = F.tid; u < LDS_BYTES / 4; u += 512) ((LAS unsigned*)F.lds)[u] = 0u;
    __syncthreads();
#endif
    if (IN(0)) {
#if DBG_ZERO & 2
        { const size_t n16 = (WS_END - WS_Q) / 16, nthr = (size_t)F.G * 512; v4u z = {0u, 0u, 0u, 0u};
          for (size_t i = (size_t)F.vcu * 512 + F.tid; i < n16; i += nthr) *((GAS v4u*)(ws + WS_Q) + i) = z; }
#endif
        P0Args A{x, args.in[1], args.in[12], args.in[13], args.in[14], args.in[17], args.in[18], XB, WIN, WBA, WBS, WO, WUP, WDN};
        p0_prologue(F, A);
    }
    SEAM(0);
    if (IN(1)) {
        pg8::Gemm g{XB, WIN, XB, WIN, NTOK, INW, DM}; pg8::StaticOrder S; S.init(NTOK, INW, F.G, (int)blockIdx.x);
        pg8::EpiInProj E{QB, GATES, args.in[11], LNPART};
        pg8::gemm_phase<pg8::EpiInProj, pg8::StaticOrder, DBG_ALIGN, DBG_SP2>(F.lds, g, S, E);
    }
    SEAM(1);
    if (IN(2)) {
        { SguArgs A{SVB, UB, LNPART, args.in[7], args.in[8], args.in[9], args.in[10]};
          for (int it = F.vcu; it < 128 * 8; it += F.G) sgu_unit_naive(F, A, it >> 3, it & 7); }
        { AttnArgs A{QB, KB, VB, QB, args.in[6], compute_lam(args.in[2], args.in[3], args.in[4], args.in[5], F.lane)};
          for (int it = F.vcu; it < NB * NH * 32; it += F.G) { const int bh = it >> 5, qb = it & 31; attn_unit_naive(F, A, bh >> 3, bh & 7, qb); } }
    }
    SEAM(2);
    if (IN(3)) {
        pg8::Gemm g{QB, WBA, UB, WBS, NTOK, DM, 1024}; pg8::TwoPartOrder S; S.init(NTOK, DM, F.G, (int)blockIdx.x);
        pg8::EpiMerge E{GATES, out, MERGED};
        pg8::gemm_phase<pg8::EpiMerge, pg8::TwoPartOrder, true, true>(F.lds, g, S, E);
    }
    SEAM(3);
    if (IN(4)) {
        pg8::Gemm g{MERGED, WO, MERGED, WO, NTOK, DM, DM}; pg8::StaticOrder S; S.init(NTOK, DM, F.G, (int)blockIdx.x);
        pg8::EpiResid E{x, out, DN_ALPHA};
        pg8::gemm_phase<pg8::EpiResid, pg8::StaticOrder, true, true>(F.lds, g, S, E);
    }
    SEAM(4);
    if (IN(5)) ln_rows(F, out, out, XB, args.in[15], args.in[16]);
    SEAM(5);
    if (IN(6)) {
        pg8::Gemm g{XB, WUP, XB, WUP, NTOK, DFF, DM}; pg8::StaticOrder S; S.init(NTOK, DFF, F.G, (int)blockIdx.x);
        pg8::EpiRelu2 E{HB};
        pg8::gemm_phase<pg8::EpiRelu2, pg8::StaticOrder, true, true>(F.lds, g, S, E);
    }
    SEAM(6);
    if (IN(7)) {
        pg8::Gemm g{HB, WDN, HB, WDN, NTOK, DM, DFF}; pg8::StaticOrder S; S.init(NTOK, DM, F.G, (int)blockIdx.x);
        pg8::EpiResid E{out, out, DN_ALPHA};
        pg8::gemm_phase<pg8::EpiResid, pg8::StaticOrder, true, true>(F.lds, g, S, E);
    }
    SEAM(7);
    if (IN(8)) ln_rows(F, out, out, nullptr, args.in[19], args.in[20]);

#if DBG_CUT >= 0
#if MK_N_LAUNCHES == 1
    cg::this_grid().sync();
    {
        const int cut = DBG_CUT;
#else
    if (lo >= 100) {
        const int cut = lo - 100;
#endif
        const size_t n = (size_t)NTOK * DM, nthr = (size_t)F.G * 512;
        for (size_t i = (size_t)F.vcu * 512 + F.tid; i < n; i += nthr) {
            const size_t r = i / DM; const int c = (int)(i % DM); float v = 0.f;
            auto bfv = [](const bf16* p) { return __uint_as_float((unsigned)(*p) << 16); };
            if (cut == 0) { v = bfv(XB + i) + bfv(WIN + (r % 9216) * 2048 + c) + bfv(WUP + (r % 8192) * 2048 + c) + bfv(WDN + (r % 2048) * 8192 + c + 2048 * ((r >> 11) & 3)) + bfv(WO + (r % 2048) * 2048 + c) + bfv(WBA + (r % 2048) * 1024 + (c & 1023)) + bfv(WBS + (r % 2048) * 1024 + (c & 1023)); }
            else if (cut == 1) { for (int k = 0; k < 3; ++k) { const int cc = c + 2048 * k; if (cc < 5120) v += bfv(QB + (size_t)(cc >> 10) * ((size_t)NTOK * 1024) + r * 1024 + (cc & 1023)); }
                            v += bfv(GATES + r * 4096 + c) + bfv(GATES + r * 4096 + 2048 + c); }
            else if (cut == 2) { v = (c < 1024) ? bfv(QB + r * 1024 + c) : bfv(UB + r * 1024 + (c - 1024)); }
            else if (cut == 3) { v = bfv(MERGED + r * 2048 + c); }
            else if (cut == 6) { for (int k = 0; k < 4; ++k) v += bfv(HB + r * 8192 + c + 2048 * k); }
            else continue;
            out[i] = v;
        }
    }
#endif
#undef IN
#undef SEAM
}

extern "C" void kernel_launch(void* const* d_in, const int* in_sizes, int n_in, void* d_out, int out_size, void* d_ws, size_t ws_size, hipStream_t stream) {
    static int grid = 0;
    if (grid == 0) {
        if (n_in != 21 || in_sizes[0] != NTOK * DM || out_size != NTOK * DM || ws_size < WS_END) {
            fprintf(stderr, "kernel_launch: unexpected shapes: n_in %d in0 %d out %d ws %zu (need >= %zu)\n", n_in, n_in > 0 ? in_sizes[0] : -1, out_size, ws_size, (size_t)WS_END); grid = -1; return; }
        int dev = 0, cus = 0, per_cu = 0;
        if (hipGetDevice(&dev) != hipSuccess || hipDeviceGetAttribute(&cus, hipDeviceAttributeMultiprocessorCount, dev) != hipSuccess) { grid = -1; return; }
        if (hipFuncSetAttribute((const void*)fwd_kernel, hipFuncAttributeMaxDynamicSharedMemorySize, LDS_BYTES) != hipSuccess) { fprintf(stderr, "kernel_launch: hipFuncSetAttribute failed\n"); grid = -1; return; }
        if (hipOccupancyMaxActiveBlocksPerMultiprocessor(&per_cu, (const void*)fwd_kernel, NWAVES * 64, LDS_BYTES) != hipSuccess || per_cu < 1) { fprintf(stderr, "kernel_launch: occupancy query says %d blocks per CU\n", per_cu); per_cu = 1; }
        (void)hipGetLastError();
        grid = cus;
        fprintf(stderr, "kernel_launch: %d CUs, occupancy query %d per CU, grid %d\n", cus, per_cu, grid);
    }
    if (grid < 0) return;
    Args a{};
    for (int i = 0; i < 21; ++i) a.in[i] = (const float*)d_in[i];
    a.out = (float*)d_out; a.ws = (unsigned char*)d_ws;
#if MK_N_LAUNCHES == 1
    a.ph_lo = 0; a.ph_hi = (DBG_CUT >= 0) ? DBG_CUT + 1 : N_PHASES;
    void* kargs[] = {&a};
    hipError_t e = hipLaunchCooperativeKernel((const void*)fwd_kernel, dim3(grid), dim3(NWAVES * 64), kargs, LDS_BYTES, stream);
    if (e != hipSuccess) fprintf(stderr, "kernel_launch: cooperative launch failed: %s (grid %d)\n", hipGetErrorString(e), grid);
#else
#if DBG_CUT >= 0
    for (int p = 0; p <= DBG_CUT; ++p) { a.ph_lo = p; a.ph_hi = p + 1; hipLaunchKernelGGL(fwd_kernel, dim3(grid), dim3(NWAVES * 64), LDS_BYTES, stream, a); }
    a.ph_lo = 100 + DBG_CUT; a.ph_hi = 100 + DBG_CUT; hipLaunchKernelGGL(fwd_kernel, dim3(grid), dim3(NWAVES * 64), LDS_BYTES, stream, a);
#else
    for (int p = 0; p < N_PHASES; ++p) {
        a.ph_lo = p; a.ph_hi = p + 1;
        hipLaunchKernelGGL(fwd_kernel, dim3(grid), dim3(NWAVES * 64), LDS_BYTES, stream, a);
    }
#endif
    const hipError_t le = hipPeekAtLastError();
    if (le != hipSuccess) fprintf(stderr, "kernel_launch: launch failed: %s\n", hipGetErrorName(le));
#endif
}
```

```cpp
#include <hip/hip_runtime.h>
#include <hip/hip_cooperative_groups.h>
#include <cstdio>
#include <cstdint>
namespace cg = cooperative_groups;

#ifndef MK_N_LAUNCHES
#define MK_N_LAUNCHES 1
#endif
#ifndef ATTN_NAIVE
#define ATTN_NAIVE 0
#endif
#ifndef SGU_NAIVE
#define SGU_NAIVE 0
#endif

#ifndef DBG_CUT
#define DBG_CUT -1
#endif

#ifndef DBG_ZERO
#define DBG_ZERO 0
#endif

#ifndef DBG_PLAIN
#define DBG_PLAIN 0
#endif
#ifndef DBG_SP2
#define DBG_SP2 true
#endif
#ifndef DBG_ALIGN
#define DBG_ALIGN true
#endif

#ifndef DBG_T1
#define DBG_T1 12
#endif

namespace pg8 {
#define PG8_LAS __attribute__((address_space(3)))
typedef unsigned short bf16_t;
typedef short bf16x8 __attribute__((ext_vector_type(8)));
typedef float f32x4 __attribute__((ext_vector_type(4)));
typedef unsigned u32x4 __attribute__((ext_vector_type(4)));
constexpr int BM = 256, BK = 64, HALF = 128, HTB = HALF * BK * 2  , STAGE_BYTES = 8 * HTB, NXCD = 8, WGM = 8;

__host__ __device__ __forceinline__ int lds_byte(int r, int c) { const int st = (r >> 4) * 2 + (c >> 5), rr = r & 15, cc = c & 31, ob = rr * 64 + cc * 2; return st * 1024 + (ob ^ (((ob >> 9) & 1) << 5)); }
__host__ __device__ __forceinline__ void stage_rc(int b, int& R, int& C) { const int st = b / 1024, sb = b % 1024, swz = sb ^ (((sb >> 9) & 1) << 5); R = (st >> 1) * 16 + swz / 64; C = (st & 1) * 32 + (swz % 64) / 2; }
__host__ __device__ __forceinline__ int perm32(int rho) { const int n = rho >> 4, i = rho & 15; return 8 * (i >> 2) + 4 * n + (i & 3); }

struct Unit { int pm, pn, part; };
struct Gemm { const bf16_t* A; const bf16_t* Bt; const bf16_t* A1; const bf16_t* Bt1; int M, N, K; };

struct StaticOrder {
    int nM, nN, nwg, G, c;
    __host__ __device__ void init(int M, int N, int G_, int c_) { nM = M / BM; nN = N / BM; nwg = nM * nN; G = G_; c = c_; }
    __host__ __device__ bool next(int i, Unit& u) const {
        const long L = (long)i * G + c; if (L >= nwg) return false;
        int wgid = (int)L; { const int q = nwg / NXCD, r = nwg % NXCD, xcd = wgid % NXCD, off = wgid / NXCD; wgid = (xcd < r ? xcd * (q + 1) : r * (q + 1) + (xcd - r) * q) + off; }
        const int nig = WGM * nN, gid = wgid / nig, fm = gid * WGM, gsz = (nM - fm) < WGM ? (nM - fm) : WGM;
        u.pm = fm + ((wgid % nig) % gsz); u.pn = (wgid % nig) / gsz; u.part = 0; return true;
    }
    __device__ __forceinline__ void a_ready(const Unit&) const {}
    __device__ __forceinline__ void done(const Unit&) const {}
};

typedef float f32x2_cv __attribute__((ext_vector_type(2))); typedef __bf16 bf16x2_cv __attribute__((ext_vector_type(2)));
__device__ __forceinline__ unsigned cvt_pk_bf16(float lo, float hi) { f32x2_cv v = {lo, hi}; bf16x2_cv b = __builtin_convertvector(v, bf16x2_cv); return __builtin_bit_cast(unsigned, b); }
typedef float f32x2 __attribute__((ext_vector_type(2)));
__device__ __forceinline__ f32x2 gelu_pk(f32x2 v) {
    const f32x2 av = __builtin_elementwise_abs(v), d = av * 0.2316418882f + 1.0f;
    f32x2 t; t.x = __builtin_amdgcn_rcpf(d.x); t.y = __builtin_amdgcn_rcpf(d.y);
    f32x2 q = t * 0.5307027145f + (-0.7265760135f); q = q * t + 0.7107068705f; q = q * t + (-0.142248368f); q = q * t + 0.127414796f; q = q * t;
    const f32x2 s = (v * v) * (-0.72134752044f);
    f32x2 e; e.x = __builtin_amdgcn_exp2f(s.x); e.y = __builtin_amdgcn_exp2f(s.y);
    const f32x2 m = v * (q * e), r = v - m;
    f32x2 o; o.x = v.x < 0.f ? m.x : r.x; o.y = v.y < 0.f ? m.y : r.y; return o;
}

constexpr float kC2 = 0.125f * 1.4426950408889634f;
__device__ __forceinline__ float bf_lo(unsigned w) { return __uint_as_float(w << 16); }
__device__ __forceinline__ float bf_hi(unsigned w) { return __uint_as_float(w & 0xffff0000u); }
__device__ __forceinline__ float sigmoidf_(float z) { return __builtin_amdgcn_rcpf(1.0f + __builtin_amdgcn_exp2f(z * -1.4426950408889634f)); }

struct TwoPartOrder {
    StaticOrder so;
    __host__ __device__ void init(int M, int N, int G_, int c_) { so.init(M, N, G_, c_); }
    __host__ __device__ bool next(int i, Unit& u) const { if (!so.next(i >> 1, u)) return false; u.part = i & 1; return true; }
    __device__ __forceinline__ void a_ready(const Unit&) const {}
    __device__ __forceinline__ void done(const Unit&) const {}
};

struct EpiInProj {
    static constexpr bool PERM = true, AFTER_DRAIN = false;
    bf16_t* qkvuv;
    bf16_t* gates;
    const float* b_gate;
    float* lnpart;
    __device__ __forceinline__ void operator()(const f32x4 (&acc)[2][2][4][2], const Unit& u, int wr, int wc, int fr, int fq) const {
        const int row0 = u.pm * BM + wr * 64 + fr; const int pn = u.pn;
#if DBG_PLAIN
        {
            const int t = pn >> 2;
            bf16_t* base = (pn < 20) ? qkvuv + (size_t)t * ((size_t)16384 * 1024) + (pn & 3) * 256 + wc * 32 + 8 * fq : gates + (pn - 20) * 256 + wc * 32 + 8 * fq;
            const size_t ld = (pn < 20) ? 1024 : 4096;
#pragma unroll
            for (int ai = 0; ai < 2; ++ai)
#pragma unroll
                for (int m = 0; m < 4; ++m) { bf16_t* rowp = base + (size_t)(row0 + ai * HALF + m * 16) * ld;
#pragma unroll
                    for (int bj = 0; bj < 2; ++bj) { const f32x4 v0 = acc[ai][bj][m][0] * 0.5f, v1 = acc[ai][bj][m][1] * 0.5f;
                        u32x4 w; w.x = cvt_pk_bf16(v0[0], v0[1]); w.y = cvt_pk_bf16(v0[2], v0[3]); w.z = cvt_pk_bf16(v1[0], v1[1]); w.w = cvt_pk_bf16(v1[2], v1[3]);
                        *(u32x4*)(rowp + bj * HALF) = w; } }
            return;
        }
#endif
        if (pn < DBG_T1) {
            const int t = pn >> 2; const float sc = (t == 0) ? kC2 : 1.0f;
            bf16_t* base = qkvuv + (size_t)t * ((size_t)16384 * 1024) + (pn & 3) * 256 + wc * 32 + 8 * fq;
#pragma unroll
            for (int ai = 0; ai < 2; ++ai)
#pragma unroll
                for (int m = 0; m < 4; ++m) { bf16_t* rowp = base + (size_t)(row0 + ai * HALF + m * 16) * 1024;
#pragma unroll
                    for (int bj = 0; bj < 2; ++bj) { const f32x4 v0 = acc[ai][bj][m][0] * sc, v1 = acc[ai][bj][m][1] * sc;
                        u32x4 w; w.x = cvt_pk_bf16(v0[0], v0[1]); w.y = cvt_pk_bf16(v0[2], v0[3]); w.z = cvt_pk_bf16(v1[0], v1[1]); w.w = cvt_pk_bf16(v1[2], v1[3]);
                        *(u32x4*)(rowp + bj * HALF) = w; } }
        } else if (pn < 20) {
            const int t = pn >> 2; const bool stats = (t == 4);
            bf16_t* base = qkvuv + (size_t)t * ((size_t)16384 * 1024) + (pn & 3) * 256 + wc * 32 + 8 * fq;
#pragma unroll
            for (int ai = 0; ai < 2; ++ai)
#pragma unroll
                for (int m = 0; m < 4; ++m) { const int row = row0 + ai * HALF + m * 16; bf16_t* rowp = base + (size_t)row * 1024; float s1 = 0.f, s2 = 0.f;
#pragma unroll
                    for (int bj = 0; bj < 2; ++bj) { const f32x4 x0 = acc[ai][bj][m][0], x1 = acc[ai][bj][m][1];
                        const f32x2 a = gelu_pk((f32x2){x0[0], x0[1]}), b = gelu_pk((f32x2){x0[2], x0[3]}), c = gelu_pk((f32x2){x1[0], x1[1]}), d = gelu_pk((f32x2){x1[2], x1[3]});
                        s1 += ((a.x + a.y) + (b.x + b.y)) + ((c.x + c.y) + (d.x + d.y));
                        s2 += ((a.x * a.x + a.y * a.y) + (b.x * b.x + b.y * b.y)) + ((c.x * c.x + c.y * c.y) + (d.x * d.x + d.y * d.y));
                        u32x4 w; w.x = cvt_pk_bf16(a.x, a.y); w.y = cvt_pk_bf16(b.x, b.y); w.z = cvt_pk_bf16(c.x, c.y); w.w = cvt_pk_bf16(d.x, d.y);
                        *(u32x4*)(rowp + bj * HALF) = w; }
                    if (stats) { s1 += __shfl_xor(s1, 16); s1 += __shfl_xor(s1, 32); s2 += __shfl_xor(s2, 16); s2 += __shfl_xor(s2, 32);
                        if (fq == 0) *(f32x2*)(lnpart + ((size_t)row * 16 + (pn - 16) * 4 + wc) * 2) = (f32x2){s1, s2}; } }
        } else {
            const int colg = (pn - 20) * 256 + wc * 32 + 8 * fq;
            f32x4 bv[2][2];
#pragma unroll
            for (int bj = 0; bj < 2; ++bj)
#pragma unroll
                for (int n = 0; n < 2; ++n) bv[bj][n] = *(const f32x4*)(b_gate + colg + bj * HALF + 4 * n);
#pragma unroll
            for (int ai = 0; ai < 2; ++ai)
#pragma unroll
                for (int m = 0; m < 4; ++m) { bf16_t* rowp = gates + (size_t)(row0 + ai * HALF + m * 16) * 4096 + colg;
#pragma unroll
                    for (int bj = 0; bj < 2; ++bj) { const f32x4 z0 = acc[ai][bj][m][0] + bv[bj][0], z1 = acc[ai][bj][m][1] + bv[bj][1];
                        u32x4 w; w.x = cvt_pk_bf16(sigmoidf_(z0[0]), sigmoidf_(z0[1])); w.y = cvt_pk_bf16(sigmoidf_(z0[2]), sigmoidf_(z0[3]));
                        w.z = cvt_pk_bf16(sigmoidf_(z1[0]), sigmoidf_(z1[1])); w.w = cvt_pk_bf16(sigmoidf_(z1[2]), sigmoidf_(z1[3]));
                        *(u32x4*)(rowp + bj * HALF) = w; } }
        }
    }
};

struct EpiMerge {
    static constexpr bool PERM = false, AFTER_DRAIN = false;
    const bf16_t* gates; float* tmp; bf16_t* merged;
    __device__ __forceinline__ void operator()(const f32x4 (&acc)[2][2][4][2], const Unit& u, int wr, int wc, int fr, int fq) const {
        typedef unsigned u32x2v __attribute__((ext_vector_type(2)));
        const int row0 = u.pm * BM + wr * 64 + fr, col0 = u.pn * BM + wc * 32 + 4 * fq; const int part = u.part;
#pragma unroll
        for (int ai = 0; ai < 2; ++ai)
#pragma unroll
            for (int m = 0; m < 4; ++m) { const size_t r = (size_t)(row0 + ai * HALF + m * 16);
#pragma unroll
                for (int bj = 0; bj < 2; ++bj)
#pragma unroll
                    for (int n = 0; n < 2; ++n) { const int c = col0 + bj * HALF + n * 16;
                        const u32x2v gw = *(const u32x2v*)(gates + r * 4096 + part * 2048 + c);
                        const f32x4 g = (f32x4){bf_lo(gw.x), bf_hi(gw.x), bf_lo(gw.y), bf_hi(gw.y)};
                        const f32x4 v = g * acc[ai][bj][m][n];
                        if (part == 0) { *(f32x4*)(tmp + r * 2048 + c) = v; }
                        else { const f32x4 o = *(const f32x4*)(tmp + r * 2048 + c) + v; u32x2v w; w.x = cvt_pk_bf16(o[0], o[1]); w.y = cvt_pk_bf16(o[2], o[3]); *(u32x2v*)(merged + r * 2048 + c) = w; } } }
        if (part == 0) asm volatile("s_waitcnt vmcnt(0)" ::: "memory");
    }
};

struct EpiResid {
    static constexpr bool PERM = false, AFTER_DRAIN = false;
    const float* base; float* out; float alpha;
    __device__ __forceinline__ void operator()(const f32x4 (&acc)[2][2][4][2], const Unit& u, int wr, int wc, int fr, int fq) const {
        const int row0 = u.pm * BM + wr * 64 + fr, col0 = u.pn * BM + wc * 32 + 4 * fq;
#pragma unroll
        for (int ai = 0; ai < 2; ++ai)
#pragma unroll
            for (int m = 0; m < 4; ++m) { const size_t r = (size_t)(row0 + ai * HALF + m * 16);
#pragma unroll
                for (int bj = 0; bj < 2; ++bj)
#pragma unroll
                    for (int n = 0; n < 2; ++n) { const size_t off = r * 2048 + col0 + bj * HALF + n * 16;
                        const f32x4 b = *(const f32x4*)(base + off); *(f32x4*)(out + off) = b * alpha + acc[ai][bj][m][n]; } }
    }
};

struct EpiRelu2 {
    static constexpr bool PERM = true, AFTER_DRAIN = false;
    bf16_t* H;
    __device__ __forceinline__ void operator()(const f32x4 (&acc)[2][2][4][2], const Unit& u, int wr, int wc, int fr, int fq) const {
        const int row0 = u.pm * BM + wr * 64 + fr, col0 = u.pn * BM + wc * 32 + 8 * fq;
#pragma unroll
        for (int ai = 0; ai < 2; ++ai)
#pragma unroll
            for (int m = 0; m < 4; ++m) { bf16_t* rowp = H + (size_t)(row0 + ai * HALF + m * 16) * 8192 + col0;
#pragma unroll
                for (int bj = 0; bj < 2; ++bj) { f32x4 v0 = acc[ai][bj][m][0], v1 = acc[ai][bj][m][1];
#pragma unroll
                    for (int e = 0; e < 4; ++e) { const float a = fmaxf(v0[e], 0.f), b = fmaxf(v1[e], 0.f); v0[e] = a * a; v1[e] = b * b; }
                    u32x4 w; w.x = cvt_pk_bf16(v0[0], v0[1]); w.y = cvt_pk_bf16(v0[2], v0[3]); w.z = cvt_pk_bf16(v1[0], v1[1]); w.w = cvt_pk_bf16(v1[2], v1[3]);
                    *(u32x4*)(rowp + bj * HALF) = w; } }
    }
};

template <class Epi, class Sched, bool ALIGN_EPI = false, bool SP2 = false>
__device__ __forceinline__ void gemm_phase(PG8_LAS unsigned char* lds, const Gemm g, const Sched& S, const Epi& E) {
    const int tid = threadIdx.x, wid = __builtin_amdgcn_readfirstlane(tid >> 6), lane = tid & 63, wr = wid >> 2, wc = wid & 3, fr = lane & 15, fq = lane >> 4;
    const int K = g.K, nt = K / BK;
    unsigned voffA[2], voffB[2];
#pragma unroll
    for (int i = 0; i < 2; ++i) { int R, C; stage_rc(tid * 16 + i * 8192, R, C); const int Rb = Epi::PERM ? ((R & ~31) + perm32(R & 31)) : R;
        voffA[i] = (unsigned)(R * K + C) * 2u; voffB[i] = (unsigned)(Rb * K + C) * 2u; }
    const size_t kstep = (size_t)(BK * 2);
    const size_t hstep = (size_t)HALF * K * 2;
    const size_t tstep = 2 * hstep;
    const unsigned ldsw = (unsigned)wid * 1024u;
    const int aoff = lds_byte(wr * 64 + fr, fq * 8), boff = lds_byte(wc * 32 + fr, fq * 8);
#define PG8_SA(b, h) (((b) * 2 + (h)) * HTB)
#define PG8_SB(b, h) ((4 + (b) * 2 + (h)) * HTB)
#define PG8_STAGE(bufoff, gbase, voff) do { _Pragma("unroll") for (int _i = 0; _i < 2; ++_i) \
        __builtin_amdgcn_global_load_lds((const unsigned*)((const char*)(gbase) + (voff)[_i]), (PG8_LAS unsigned*)(lds + (bufoff) + ldsw + _i * 8192), 16, 0, 0); } while (0)
#define PG8_LDA(dst, b, h) do { _Pragma("unroll") for (int m = 0; m < 4; ++m) _Pragma("unroll") for (int k = 0; k < 2; ++k) dst[m][k] = *(const PG8_LAS bf16x8*)(lds + PG8_SA(b, h) + aoff + m * 2048 + k * 1024); } while (0)
#define PG8_LDB(dst, b, h) do { _Pragma("unroll") for (int n = 0; n < 2; ++n) _Pragma("unroll") for (int k = 0; k < 2; ++k) dst[n][k] = *(const PG8_LAS bf16x8*)(lds + PG8_SB(b, h) + boff + n * 2048 + k * 1024); } while (0)
#define PG8_MMA(ai, bj, At, Bt) do { __builtin_amdgcn_s_setprio(1); _Pragma("unroll") for (int m = 0; m < 4; ++m) _Pragma("unroll") for (int n = 0; n < 2; ++n) _Pragma("unroll") for (int k = 0; k < 2; ++k) \
        acc[ai][bj][m][n] = __builtin_amdgcn_mfma_f32_16x16x32_bf16(Bt[n][k], At[m][k], acc[ai][bj][m][n], 0, 0, 0); __builtin_amdgcn_s_setprio(0); } while (0)
#define PG8_WAIT_V(n) asm volatile("s_waitcnt vmcnt(" #n ")" ::: "memory")
#define PG8_WAIT_L(n) asm volatile("s_waitcnt lgkmcnt(" #n ")" ::: "memory")
#define PG8_BAR __builtin_amdgcn_s_barrier()
#define PG8_SCHED __builtin_amdgcn_sched_barrier(0)
    Unit cur, nxt; int ui = 0;
    if (!S.next(0, cur)) return;
    f32x4 acc[2][2][4][2];
#pragma unroll
    for (int a = 0; a < 2; ++a)
#pragma unroll
        for (int b = 0; b < 2; ++b)
#pragma unroll
            for (int m = 0; m < 4; ++m)
#pragma unroll
                for (int n = 0; n < 2; ++n) acc[a][b][m][n] = (f32x4){0.f, 0.f, 0.f, 0.f};
    bf16x8 At[4][2], B0[2][2], B1[2][2];
    const char* cA = (const char*)(cur.part ? g.A1 : g.A) + (size_t)cur.pm * tstep; const char* cB = (const char*)(cur.part ? g.Bt1 : g.Bt) + (size_t)cur.pn * tstep;
    S.a_ready(cur);
    if constexpr (SP2) {
        PG8_STAGE(PG8_SB(0, 0), cB, voffB); PG8_STAGE(PG8_SB(0, 1), cB + hstep, voffB); PG8_STAGE(PG8_SA(0, 0), cA, voffA); PG8_STAGE(PG8_SA(0, 1), cA + hstep, voffA);
        if (wr == 1) PG8_BAR;
        PG8_WAIT_V(2); PG8_BAR;
        PG8_STAGE(PG8_SB(1, 0), cB + kstep, voffB); PG8_STAGE(PG8_SA(1, 0), cA + kstep, voffA); PG8_STAGE(PG8_SB(1, 1), cB + hstep + kstep, voffB);
        PG8_WAIT_V(6); PG8_BAR;
    } else {
        PG8_STAGE(PG8_SB(0, 0), cB, voffB); PG8_STAGE(PG8_SA(0, 0), cA, voffA); PG8_STAGE(PG8_SB(0, 1), cB + hstep, voffB); PG8_STAGE(PG8_SA(0, 1), cA + hstep, voffA);
        if (wr == 1) PG8_BAR;
        PG8_WAIT_V(4); PG8_BAR;
        PG8_STAGE(PG8_SB(1, 0), cB + kstep, voffB); PG8_STAGE(PG8_SA(1, 0), cA + kstep, voffA); PG8_STAGE(PG8_SB(1, 1), cB + hstep + kstep, voffB);
        PG8_WAIT_V(6); PG8_BAR;
    }
    for (;;) {
        const bool has_next = S.next(ui + 1, nxt);
        const char* nA = has_next ? (const char*)(nxt.part ? g.A1 : g.A) + (size_t)nxt.pm * tstep : cA; const char* nB = has_next ? (const char*)(nxt.part ? g.Bt1 : g.Bt) + (size_t)nxt.pn * tstep : cB;
        for (int t = 0; t < nt; t += 2) {
            const bool last = (t == nt - 2);
            const char* a1 = cA + (size_t)(t + 1) * kstep;
            const char* a2 = last ? nA : cA + (size_t)(t + 2) * kstep; const char* b2 = last ? nB : cB + (size_t)(t + 2) * kstep;
            const char* a3 = a2 + kstep; const char* b3 = b2 + kstep;
            if (last && has_next) S.a_ready(nxt);
            if constexpr (SP2) {
            PG8_LDB(B0, 0, 0); PG8_LDB(B1, 0, 1); PG8_SCHED; PG8_LDA(At, 0, 0); PG8_STAGE(PG8_SA(1, 1), a1 + hstep, voffA);
            PG8_WAIT_V(8); PG8_WAIT_L(0); PG8_BAR; PG8_MMA(0, 0, At, B0); PG8_MMA(0, 1, At, B1); PG8_BAR; PG8_SCHED;
            PG8_LDA(At, 0, 1); PG8_STAGE(PG8_SB(0, 0), b2, voffB); PG8_STAGE(PG8_SB(0, 1), b2 + hstep, voffB); PG8_STAGE(PG8_SA(0, 0), a2, voffA);
            PG8_WAIT_V(8); PG8_WAIT_L(0); PG8_BAR; PG8_MMA(1, 0, At, B0); PG8_MMA(1, 1, At, B1); PG8_BAR; PG8_SCHED;
            PG8_LDB(B0, 1, 0); PG8_LDB(B1, 1, 1); PG8_SCHED; PG8_LDA(At, 1, 0); PG8_STAGE(PG8_SA(0, 1), a2 + hstep, voffA);
            PG8_WAIT_V(8); PG8_WAIT_L(0); PG8_BAR; PG8_MMA(0, 0, At, B0); PG8_MMA(0, 1, At, B1); PG8_BAR; PG8_SCHED;
            PG8_LDA(At, 1, 1); PG8_STAGE(PG8_SB(1, 0), b3, voffB); PG8_STAGE(PG8_SB(1, 1), b3 + hstep, voffB); PG8_STAGE(PG8_SA(1, 0), a3, voffA);
            PG8_WAIT_V(8); PG8_WAIT_L(0); PG8_BAR; PG8_MMA(1, 0, At, B0); PG8_MMA(1, 1, At, B1); PG8_BAR; PG8_SCHED;
            } else {
            PG8_LDB(B0, 0, 0); PG8_SCHED; PG8_LDA(At, 0, 0); PG8_STAGE(PG8_SA(1, 1), a1 + hstep, voffA);
            PG8_WAIT_L(8); PG8_BAR; PG8_WAIT_L(0); PG8_MMA(0, 0, At, B0); PG8_BAR; PG8_SCHED;
            PG8_LDB(B1, 0, 1); PG8_STAGE(PG8_SB(0, 0), b2, voffB);
            PG8_BAR; PG8_WAIT_L(0); PG8_MMA(0, 1, At, B1); PG8_BAR;
            PG8_LDA(At, 0, 1); PG8_STAGE(PG8_SA(0, 0), a2, voffA);
            PG8_BAR; PG8_WAIT_L(0); PG8_MMA(1, 0, At, B0); PG8_BAR; PG8_SCHED;
            PG8_STAGE(PG8_SB(0, 1), b2 + hstep, voffB);
            PG8_WAIT_V(6); PG8_BAR; PG8_MMA(1, 1, At, B1); PG8_BAR;
            PG8_LDB(B0, 1, 0); PG8_SCHED; PG8_LDA(At, 1, 0); PG8_STAGE(PG8_SA(0, 1), a2 + hstep, voffA);
            PG8_WAIT_L(8); PG8_BAR; PG8_WAIT_L(0); PG8_MMA(0, 0, At, B0); PG8_BAR; PG8_SCHED;
            PG8_LDB(B1, 1, 1); PG8_STAGE(PG8_SB(1, 0), b3, voffB);
            PG8_BAR; PG8_WAIT_L(0); PG8_MMA(0, 1, At, B1); PG8_BAR;
            PG8_LDA(At, 1, 1); PG8_STAGE(PG8_SA(1, 0), a3, voffA);
            PG8_BAR; PG8_WAIT_L(0); PG8_MMA(1, 0, At, B0); PG8_BAR; PG8_SCHED;
            PG8_STAGE(PG8_SB(1, 1), b3 + hstep, voffB);
            PG8_WAIT_V(6); PG8_BAR; PG8_MMA(1, 1, At, B1); PG8_BAR;
            }
        }
        if constexpr (ALIGN_EPI) { if (wr == 0) PG8_BAR; }
        if constexpr (!Epi::AFTER_DRAIN) { E(acc, cur, wr, wc, fr, fq); S.done(cur); }
        if (!has_next) break;
#pragma unroll
        for (int a = 0; a < 2; ++a)
#pragma unroll
            for (int b = 0; b < 2; ++b)
#pragma unroll
                for (int m = 0; m < 4; ++m)
#pragma unroll
                    for (int n = 0; n < 2; ++n) acc[a][b][m][n] = (f32x4){0.f, 0.f, 0.f, 0.f};
        cur = nxt; cA = nA; cB = nB; ++ui;
        if constexpr (ALIGN_EPI) { if (wr == 1) PG8_BAR; }
    }
    PG8_WAIT_V(0);
    if constexpr (!ALIGN_EPI) { if (wr == 0) PG8_BAR; }
    PG8_BAR;
    if constexpr (Epi::AFTER_DRAIN) { E.fused(acc, cur, wr, wc, fr, fq, lds, wid, lane); S.done(cur); }
#undef PG8_SA
#undef PG8_SB
#undef PG8_STAGE
#undef PG8_LDA
#undef PG8_LDB
#undef PG8_MMA
#undef PG8_WAIT_V
#undef PG8_WAIT_L
#undef PG8_BAR
#undef PG8_SCHED
}
}

#define GAS __attribute__((address_space(1)))
#define LAS __attribute__((address_space(3)))
typedef unsigned short bf16;
typedef unsigned v4u __attribute__((ext_vector_type(4)));
typedef unsigned v2u __attribute__((ext_vector_type(2)));
typedef float f32x4 __attribute__((ext_vector_type(4)));
typedef float f32x2 __attribute__((ext_vector_type(2)));
typedef short bf16x8 __attribute__((ext_vector_type(8)));

constexpr int NB = 4, SEQ = 4096, NTOK = NB * SEQ, DM = 2048, INW = 9216, NH = 8, QKW = 1024, SGW = 1024, DFF = 8192;
constexpr float LN_EPS = 1e-5f;
constexpr float DN_ALPHA = 1.189207115002721f;
constexpr float LAMBDA_INIT = 0.2f;
constexpr int NWAVES = 8;

constexpr size_t MiB = 1u << 20;
constexpr size_t WS_CTL = 0, CTL_ZERO_BYTES = 1 * MiB;
constexpr size_t WS_LNPART = 2 * MiB;
constexpr size_t WS_WIN = 4 * MiB;
constexpr size_t WS_WBA = 40 * MiB;
constexpr size_t WS_WBS = 44 * MiB;
constexpr size_t WS_WO = 48 * MiB;
constexpr size_t WS_WUP = 56 * MiB;
constexpr size_t WS_WDN = 88 * MiB;
constexpr size_t WS_XB = 120 * MiB;
constexpr size_t WS_Q = 184 * MiB, WS_K = 216 * MiB, WS_V = 248 * MiB, WS_U = 280 * MiB, WS_SV = 312 * MiB;
constexpr size_t WS_GATES = 344 * MiB;
constexpr size_t WS_MERGED = WS_K;
constexpr size_t WS_H = WS_Q;
constexpr size_t WS_END = 472 * MiB;
static_assert(WS_H + (size_t)NTOK * DFF * 2 <= WS_END && WS_GATES + (size_t)NTOK * 4096 * 2 == WS_END, "d_ws map");

constexpr int LDS_BYTES = 147456;

__device__ __forceinline__ unsigned f2bf(float f) { unsigned u = __builtin_bit_cast(unsigned, f); return (u + 0x7fffu + ((u >> 16) & 1u)) >> 16; }
__device__ __forceinline__ unsigned pk2(float lo, float hi) { return f2bf(lo) | (f2bf(hi) << 16); }
__device__ __forceinline__ float bflo(unsigned w) { return __uint_as_float(w << 16); }
__device__ __forceinline__ float bfhi(unsigned w) { return __uint_as_float(w & 0xffff0000u); }
#define LDS_WAIT() asm volatile("s_waitcnt lgkmcnt(0)" ::: "memory")

struct Frame {
    LAS unsigned char* lds;
    int tid, lane, wave, vcu, G;
};

__device__ __forceinline__ float wave_sum(float v) {
#pragma unroll
    for (int o = 1; o < 64; o <<= 1) v += __shfl_xor(v, o);
    return v;
}

__device__ __forceinline__ void p0_transpose_item(const float* W, int K, int N, bf16* WT, LAS float* scr, int item, int lane) {
    const int nblk = N / 32, kb = item / nblk, nb = item % nblk, k0 = 64 * kb, n0 = 32 * nb;
#pragma unroll 8
    for (int i = 0; i < 32; ++i) { const int kk = 2 * i + (lane >> 5); scr[kk * 33 + (lane & 31)] = W[(size_t)(k0 + kk) * N + n0 + (lane & 31)]; }
    LDS_WAIT(); asm volatile("" ::: "memory");
    const int c = lane & 7;
#pragma unroll
    for (int j = 0; j < 4; ++j) { const int n = (lane >> 3) + 8 * j; const LAS float* s = scr + (8 * c) * 33 + n;
        v4u o; o.x = pk2(s[0 * 33], s[1 * 33]); o.y = pk2(s[2 * 33], s[3 * 33]); o.z = pk2(s[4 * 33], s[5 * 33]); o.w = pk2(s[6 * 33], s[7 * 33]);
        *(GAS v4u*)(WT + (size_t)(n0 + n) * K + k0 + 8 * c) = o; }
    LDS_WAIT(); asm volatile("" ::: "memory");
}

struct P0Args { const float *x, *w_in, *w_ba, *w_bs, *w_o, *w_up, *w_dn; bf16 *xb, *win_t, *wba_t, *wbs_t, *wo_t, *wup_t, *wdn_t; };
__device__ __forceinline__ void p0_prologue(const Frame& F, const P0Args& A) {
    LAS float* scr = (LAS float*)(F.lds + F.wave * 16384);
    const int gw = F.vcu * NWAVES + F.wave, NGW = F.G * NWAVES;
    constexpr int I_IN = (DM / 64) * (INW / 32), I_BA = (1024 / 64) * (DM / 32), I_O = (DM / 64) * (DM / 32), I_UP = (DM / 64) * (DFF / 32), I_DN = (DFF / 64) * (DM / 32);
    constexpr int NITEMS = I_IN + 2 * I_BA + I_O + I_UP + I_DN;
    for (int it = gw; it < NITEMS; it += NGW) {
        int r = it;
        if (r < I_IN) { p0_transpose_item(A.w_in, DM, INW, A.win_t, scr, r, F.lane); continue; } r -= I_IN;
        if (r < I_BA) { p0_transpose_item(A.w_ba, 1024, DM, A.wba_t, scr, r, F.lane); continue; } r -= I_BA;
        if (r < I_BA) { p0_transpose_item(A.w_bs, 1024, DM, A.wbs_t, scr, r, F.lane); continue; } r -= I_BA;
        if (r < I_O) { p0_transpose_item(A.w_o, DM, DM, A.wo_t, scr, r, F.lane); continue; } r -= I_O;
        if (r < I_UP) { p0_transpose_item(A.w_up, DM, DFF, A.wup_t, scr, r, F.lane); continue; } r -= I_UP;
        p0_transpose_item(A.w_dn, DFF, DM, A.wdn_t, scr, r, F.lane);
    }
    const size_t n8 = (size_t)NTOK * DM / 8, nthr = (size_t)F.G * 512;
    for (size_t i = (size_t)F.vcu * 512 + F.tid; i < n8; i += nthr) {
        const f32x4 a = *(const GAS f32x4*)(A.x + i * 8), b = *(const GAS f32x4*)(A.x + i * 8 + 4);
        v4u o; o.x = pk2(a.x, a.y); o.y = pk2(a.z, a.w); o.z = pk2(b.x, b.y); o.w = pk2(b.z, b.w);
        *(GAS v4u*)(A.xb + i * 8) = o;
    }
}

__device__ __forceinline__ void ln_rows(const Frame& F, const float* in, float* outf, bf16* outb, const float* g, const float* b) {
    const int gw = F.vcu * NWAVES + F.wave, NGW = F.G * NWAVES;
    for (int m = gw; m < NTOK; m += NGW) {
        const GAS f32x4* xr = (const GAS f32x4*)(in + (size_t)m * DM) + F.lane;
        f32x4 v[8]; float s = 0.f;
#pragma unroll
        for (int j = 0; j < 8; ++j) { v[j] = xr[64 * j]; s += (v[j].x + v[j].y) + (v[j].z + v[j].w); }
        const float mean = wave_sum(s) * (1.f / DM); float s2 = 0.f;
#pragma unroll
        for (int j = 0; j < 8; ++j) { v[j] = v[j] - mean; s2 += (v[j].x * v[j].x + v[j].y * v[j].y) + (v[j].z * v[j].z + v[j].w * v[j].w); }
        const float rstd = 1.0f / sqrtf(wave_sum(s2) * (1.f / DM) + LN_EPS);
#pragma unroll
        for (int j = 0; j < 8; ++j) {
            const f32x4 gg = *((const GAS f32x4*)g + F.lane + 64 * j), bb = *((const GAS f32x4*)b + F.lane + 64 * j);
            const f32x4 y = v[j] * rstd * gg + bb;
            if (outf) *((GAS f32x4*)(outf + (size_t)m * DM) + F.lane + 64 * j) = y;
            if (outb) { v2u w; w.x = pk2(y.x, y.y); w.y = pk2(y.z, y.w); *((GAS v2u*)(outb + (size_t)m * DM) + F.lane + 64 * j) = w; }
        }
    }
}

__device__ __forceinline__ float compute_lam(const float* lq1, const float* lk1, const float* lq2, const float* lk2, int lane) {
    const float a = wave_sum(lq1[lane] * lk1[lane]), b = wave_sum(lq2[lane] * lk2[lane]);
    return expf(a) - expf(b) + LAMBDA_INIT;
}

struct SguArgs { const bf16* sv; bf16* u; const float* lnpart; const float *ln_g, *ln_b, *w_s, *b_s; };
__device__ __forceinline__ void sgu_unit_naive(const Frame& F, const SguArgs& A, int c, int g) {
    LAS float* vn = (LAS float*)F.lds;
    const int tid = F.tid, s = tid >> 2, dq = (tid & 3) * 32; const size_t row = (size_t)c * 128 + s;
    {
        float s1 = 0.f, s2 = 0.f;
#pragma unroll
        for (int p = 0; p < 16; ++p) { const f32x2 t = *(const GAS f32x2*)(A.lnpart + (row * 16 + p) * 2); s1 += t.x; s2 += t.y; }
        const float mean = s1 * (1.f / SGW), var = fmaxf(s2 * (1.f / SGW) - mean * mean, 0.f), rstd = 1.0f / sqrtf(var + LN_EPS);
        const GAS v4u* src = (const GAS v4u*)(A.sv + row * SGW + g * 128 + dq);
#pragma unroll
        for (int q = 0; q < 4; ++q) { const v4u w = src[q]; const int d0 = dq + 8 * q; const int ch = g * 128 + d0;
            float x[8] = {bflo(w.x), bfhi(w.x), bflo(w.y), bfhi(w.y), bflo(w.z), bfhi(w.z), bflo(w.w), bfhi(w.w)};
#pragma unroll
            for (int e = 0; e < 8; ++e) vn[s * 128 + d0 + e] = (x[e] - mean) * rstd * A.ln_g[ch + e] + A.ln_b[ch + e]; }
    }
    __syncthreads();
    const int t = s; float acc[32];
#pragma unroll
    for (int e = 0; e < 32; ++e) acc[e] = 0.f;
    const float* wrow = A.w_s + ((size_t)g * 128 + t) * 128;
    for (int ss = 0; ss < 128; ++ss) { const float w = wrow[ss]; const LAS f32x4* vr = (const LAS f32x4*)(vn + ss * 128 + dq);
#pragma unroll
        for (int q = 0; q < 8; ++q) { const f32x4 v = vr[q]; acc[4 * q] += w * v.x; acc[4 * q + 1] += w * v.y; acc[4 * q + 2] += w * v.z; acc[4 * q + 3] += w * v.w; } }
    const float bs = A.b_s[g * 128 + t];
    GAS v4u* up = (GAS v4u*)(A.u + row * SGW + g * 128 + dq);
#pragma unroll
    for (int q = 0; q < 4; ++q) { const v4u w = up[q]; v4u o;
        o.x = pk2(bflo(w.x) * (acc[8 * q + 0] + bs), bfhi(w.x) * (acc[8 * q + 1] + bs)); o.y = pk2(bflo(w.y) * (acc[8 * q + 2] + bs), bfhi(w.y) * (acc[8 * q + 3] + bs));
        o.z = pk2(bflo(w.z) * (acc[8 * q + 4] + bs), bfhi(w.z) * (acc[8 * q + 5] + bs)); o.w = pk2(bflo(w.w) * (acc[8 * q + 6] + bs), bfhi(w.w) * (acc[8 * q + 7] + bs));
        up[q] = o; }
    __syncthreads();
}

struct AttnArgs { const bf16* q; const bf16* k; const bf16* v; bf16* o; const float* gain; float lam; };
__device__ __forceinline__ void attn_unit_naive(const Frame& F, const AttnArgs& A, int b, int h, int qb) {
    LAS unsigned char* lds = F.lds;
    LAS bf16* Ks = (LAS bf16*)lds; LAS bf16* Vs = (LAS bf16*)(lds + 8192);
    const int tid = F.tid, r = tid & 127, c = (tid >> 7) & 1, half = tid >> 8;
    const size_t rowbase = (size_t)b * SEQ; const int qpos = qb * 128 + r;
    float q[64];
    { const GAS v4u* qp = (const GAS v4u*)(A.q + (rowbase + qpos) * QKW + h * 128 + c * 64);
#pragma unroll
      for (int i = 0; i < 8; ++i) { const v4u w = qp[i]; q[8 * i] = bflo(w.x); q[8 * i + 1] = bfhi(w.x); q[8 * i + 2] = bflo(w.y); q[8 * i + 3] = bfhi(w.y); q[8 * i + 4] = bflo(w.z); q[8 * i + 5] = bfhi(w.z); q[8 * i + 6] = bflo(w.w); q[8 * i + 7] = bfhi(w.w); } }
    float o[64];
#pragma unroll
    for (int d = 0; d < 64; ++d) o[d] = 0.f;
    float m = -1e30f, l = 0.f;
    const float slope2 = __builtin_amdgcn_exp2f(-(float)(h + 1)) * 1.4426950408889634f;
    const int skey = tid >> 4, sch = (tid & 15) * 8;
    for (int kt = 0; kt < SEQ / 32; ++kt) {
        __syncthreads();
        { const size_t grow = (rowbase + (size_t)kt * 32 + skey) * QKW + h * 128 + sch;
          *(LAS v4u*)(Ks + skey * 128 + sch) = *(const GAS v4u*)(A.k + grow);
          *(LAS v4u*)(Vs + skey * 128 + sch) = *(const GAS v4u*)(A.v + grow); }
        __syncthreads();
        for (int j = 0; j < 32; ++j) {
            const LAS v4u* kp = (const LAS v4u*)(Ks + j * 128 + c * 64);
            float dot = 0.f;
#pragma unroll
            for (int i = 0; i < 8; ++i) { const v4u w = kp[i];
                dot += q[8 * i] * bflo(w.x) + q[8 * i + 1] * bfhi(w.x) + q[8 * i + 2] * bflo(w.y) + q[8 * i + 3] * bfhi(w.y) + q[8 * i + 4] * bflo(w.z) + q[8 * i + 5] * bfhi(w.z) + q[8 * i + 6] * bflo(w.w) + q[8 * i + 7] * bfhi(w.w); }
            const float t = dot - slope2 * fabsf((float)(qpos - (kt * 32 + j)));
            const float mn = fmaxf(m, t), al = __builtin_amdgcn_exp2f(m - mn), p = __builtin_amdgcn_exp2f(t - mn);
            l = l * al + p; m = mn;
            const LAS v4u* vp = (const LAS v4u*)(Vs + j * 128 + half * 64);
#pragma unroll
            for (int i = 0; i < 8; ++i) { const v4u w = vp[i];
                o[8 * i] = o[8 * i] * al + p * bflo(w.x); o[8 * i + 1] = o[8 * i + 1] * al + p * bfhi(w.x); o[8 * i + 2] = o[8 * i + 2] * al + p * bflo(w.y); o[8 * i + 3] = o[8 * i + 3] * al + p * bfhi(w.y);
                o[8 * i + 4] = o[8 * i + 4] * al + p * bflo(w.z); o[8 * i + 5] = o[8 * i + 5] * al + p * bfhi(w.z); o[8 * i + 6] = o[8 * i + 6] * al + p * bflo(w.w); o[8 * i + 7] = o[8 * i + 7] * al + p * bfhi(w.w); }
        }
    }
    __syncthreads();
    LAS float* Ax = (LAS float*)lds;
    { const float rl = 1.0f / l; LAS float* dst = Ax + ((size_t)c * 128 + r) * 128 + half * 64;
#pragma unroll
      for (int d = 0; d < 64; ++d) dst[d] = o[d] * rl; }
    __syncthreads();
    { const int r2 = tid >> 2, qd = (tid & 3) * 32; float x[32]; float ss = 0.f;
#pragma unroll
      for (int e = 0; e < 32; ++e) { x[e] = Ax[(size_t)r2 * 128 + qd + e] - A.lam * Ax[(size_t)(128 + r2) * 128 + qd + e]; ss += x[e] * x[e]; }
      ss += __shfl_xor(ss, 1); ss += __shfl_xor(ss, 2);
      const float rstd = 1.0f / sqrtf(ss * (1.f / 128.f) + LN_EPS) * (1.0f - LAMBDA_INIT);
      GAS v4u* op = (GAS v4u*)(A.o + (rowbase + (size_t)qb * 128 + r2) * QKW + h * 128 + qd);
#pragma unroll
      for (int i = 0; i < 4; ++i) { v4u w;
          w.x = pk2(x[8 * i] * rstd * A.gain[qd + 8 * i], x[8 * i + 1] * rstd * A.gain[qd + 8 * i + 1]); w.y = pk2(x[8 * i + 2] * rstd * A.gain[qd + 8 * i + 2], x[8 * i + 3] * rstd * A.gain[qd + 8 * i + 3]);
          w.z = pk2(x[8 * i + 4] * rstd * A.gain[qd + 8 * i + 4], x[8 * i + 5] * rstd * A.gain[qd + 8 * i + 5]); w.w = pk2(x[8 * i + 6] * rstd * A.gain[qd + 8 * i + 6], x[8 * i + 7] * rstd * A.gain[qd + 8 * i + 7]);
          op[i] = w; } }
    __syncthreads();
}


namespace att {
using bf16x8 = __attribute__((ext_vector_type(8))) short;
using s16x4  = __attribute__((ext_vector_type(4))) short;
using f32x16 = __attribute__((ext_vector_type(16))) float;
using u32x4  = __attribute__((ext_vector_type(4))) unsigned;
typedef float f32x2_t __attribute__((ext_vector_type(2))); typedef __bf16 bf16x2_t __attribute__((ext_vector_type(2)));
constexpr int KVBLK = 64, LDQK = 1024;
constexpr int SHM_V = KVBLK * 128 * 2, SHM_K = KVBLK * 128 * 2;
constexpr int OFF_V = 0, OFF_K = 2 * SHM_V, OFF_WS = 2 * SHM_V + 2 * SHM_K, OFF_XCH = OFF_WS + 8 * 64 * 4, ATT_LDS = OFF_XCH + 4 * 32 * 128 * 4;
constexpr float THR2 = 8.0f;
#define KSWZ(row, colB) ((row) * 256 + ((colB) ^ (((row) & 7) << 4)))
#define SBAR() __builtin_amdgcn_sched_barrier(0)
__device__ __forceinline__ int crow(int r, int hi) { return (r & 3) + 8 * (r >> 2) + 4 * hi; }
__device__ __forceinline__ unsigned cvtpk(float lo, float hi) { f32x2_t v = {lo, hi}; bf16x2_t b = __builtin_convertvector(v, bf16x2_t); return __builtin_bit_cast(unsigned, b); }

__device__ __forceinline__ void partialSM(f32x16& p0, f32x16& p1, float kb, float nslope, float& m_reg, float& mn, float& alpha) {
#pragma unroll
  for (int r = 0; r < 16; ++r) { const float cr = (float)((r & 3) + 8 * (r >> 2));
    p0[r] = fmaf(nslope, fabsf(kb + cr), p0[r]); p1[r] = fmaf(nslope, fabsf(kb + (cr + 32.0f)), p1[r]); }
  float pmax = p0[0];
#pragma unroll
  for (int r = 1; r < 16; ++r) pmax = fmaxf(pmax, p0[r]);
#pragma unroll
  for (int r = 0; r < 16; ++r) pmax = fmaxf(pmax, p1[r]);
  { auto rr = __builtin_amdgcn_permlane32_swap(__float_as_uint(pmax), __float_as_uint(pmax), false, false);
    pmax = fmaxf(__uint_as_float(rr[0]), __uint_as_float(rr[1])); }
  if (__builtin_expect(__all(pmax - m_reg <= THR2), 1)) { mn = m_reg; alpha = 1.f; }
  else { mn = fmaxf(m_reg, pmax); alpha = __builtin_amdgcn_exp2f(m_reg - mn); m_reg = mn; }
#pragma unroll
  for (int r = 0; r < 16; ++r) { p0[r] -= mn; p1[r] -= mn; }
#pragma unroll
  for (int r = 0; r < 16; ++r) p0[r] = __builtin_amdgcn_exp2f(p0[r]);
}
__device__ __forceinline__ void finishSM(f32x16& p0, f32x16& p1, float alpha, float& l_reg, bf16x8& pa0, bf16x8& pa1, bf16x8& pa2, bf16x8& pa3) {
#pragma unroll
  for (int r = 0; r < 16; ++r) p1[r] = __builtin_amdgcn_exp2f(p1[r]);
  float ps = 0;
#pragma unroll
  for (int r = 0; r < 16; ++r) ps += p0[r];
#pragma unroll
  for (int r = 0; r < 16; ++r) ps += p1[r];
  { auto rr = __builtin_amdgcn_permlane32_swap(__float_as_uint(ps), __float_as_uint(ps), false, false);
    ps = __uint_as_float(rr[0]) + __uint_as_float(rr[1]); }
  l_reg = l_reg * alpha + ps;
#define PK4(P, BASE, OUT) do { unsigned a0 = cvtpk(P[BASE + 0], P[BASE + 1]), a1 = cvtpk(P[BASE + 2], P[BASE + 3]);   \
    unsigned b0 = cvtpk(P[BASE + 4], P[BASE + 5]), b1 = cvtpk(P[BASE + 6], P[BASE + 7]);                              \
    auto r0 = __builtin_amdgcn_permlane32_swap(a0, b0, false, false); auto r1 = __builtin_amdgcn_permlane32_swap(a1, b1, false, false); \
    u32x4 w = {r0[0], r1[0], r0[1], r1[1]}; OUT = __builtin_bit_cast(bf16x8, w); } while (0)
  PK4(p0, 0, pa0); PK4(p0, 8, pa1); PK4(p1, 0, pa2); PK4(p1, 8, pa3);
#undef PK4
}
__device__ __forceinline__ void qkt(f32x16& p0, f32x16& p1, const LAS char* Ks, const bf16x8* qr, int r32, int cbase) {
  p0 = f32x16{}; p1 = f32x16{};
#pragma unroll
  for (int d0 = 0; d0 < 4; ++d0) { const int cb = cbase + d0 * 32;
    const bf16x8 b0 = *(const LAS bf16x8*)(Ks + KSWZ(r32, cb));
    const bf16x8 b1 = *(const LAS bf16x8*)(Ks + KSWZ(32 + r32, cb));
    p0 = __builtin_amdgcn_mfma_f32_32x32x16_bf16(b0, qr[d0], p0, 0, 0, 0);
    p1 = __builtin_amdgcn_mfma_f32_32x32x16_bf16(b1, qr[d0], p1, 0, 0, 0); }
}
__device__ __forceinline__ int v_st(int k, int c) { const int kk = (k & ~0xC) | ((k & 4) << 1) | ((k & 8) >> 1); return ((kk >> 3) * 4 + (c >> 5)) * 512 + ((kk & 7) * 32 + (c & 31)) * 2; }
__device__ __forceinline__ int v_rd_base(int lane) { return ((lane & 3) << 3) | (((lane >> 2) & 3) << 6) | (((lane >> 4) & 1) << 5) | (((lane >> 5) & 1) << 8); }
constexpr int v_rd_off(int d0, int ks, int half) { return d0 * 512 + ks * 4096 + half * 2048; }
template <int OFF> __device__ __forceinline__ s16x4 tr_read(int vb) {
  s16x4 r; asm volatile("ds_read_b64_tr_b16 %0, %1 offset:%2" : "=&v"(r) : "v"(vb), "i"(OFF) : "memory"); return r;
}
template <int D0> __device__ __forceinline__ void pv_one(f32x16& od, int vb, bf16x8 pa0, bf16x8 pa1, bf16x8 pa2, bf16x8 pa3) {
  const s16x4 l0 = tr_read<v_rd_off(D0, 0, 0)>(vb), h0 = tr_read<v_rd_off(D0, 0, 1)>(vb), l1 = tr_read<v_rd_off(D0, 1, 0)>(vb), h1 = tr_read<v_rd_off(D0, 1, 1)>(vb);
  const s16x4 l2 = tr_read<v_rd_off(D0, 2, 0)>(vb), h2 = tr_read<v_rd_off(D0, 2, 1)>(vb), l3 = tr_read<v_rd_off(D0, 3, 0)>(vb), h3 = tr_read<v_rd_off(D0, 3, 1)>(vb);
  asm volatile("s_waitcnt lgkmcnt(0)" ::: "memory"); SBAR();
#define PK(L, H) (bf16x8){L[0], L[1], L[2], L[3], H[0], H[1], H[2], H[3]}
  od = __builtin_amdgcn_mfma_f32_32x32x16_bf16(pa0, PK(l0, h0), od, 0, 0, 0);
  od = __builtin_amdgcn_mfma_f32_32x32x16_bf16(pa1, PK(l1, h1), od, 0, 0, 0);
  od = __builtin_amdgcn_mfma_f32_32x32x16_bf16(pa2, PK(l2, h2), od, 0, 0, 0);
  od = __builtin_amdgcn_mfma_f32_32x32x16_bf16(pa3, PK(l3, h3), od, 0, 0, 0);
#undef PK
}
__device__ __forceinline__ void pv_d0(f32x16* o, int vb, bf16x8 pa0, bf16x8 pa1, bf16x8 pa2, bf16x8 pa3) {
  pv_one<0>(o[0], vb, pa0, pa1, pa2, pa3); pv_one<1>(o[1], vb, pa0, pa1, pa2, pa3); pv_one<2>(o[2], vb, pa0, pa1, pa2, pa3); pv_one<3>(o[3], vb, pa0, pa1, pa2, pa3);
}

__device__ __forceinline__ void attn_unit(int b, int h, int qb, const bf16* Q, const bf16* __restrict__ K, const bf16* __restrict__ V, bf16* O, const float* gain, float lam, LAS char* lds) {
  const int tid = threadIdx.x, lane = tid & 63, r32 = lane & 31, hi = lane >> 5; const int wid = __builtin_amdgcn_readfirstlane(tid >> 6);
  const int c = wid >> 2, g4 = wid & 3;
  LAS char* V_lds = lds + OFF_V; LAS char* K_lds = lds + OFF_K;
  LAS float* ws = (LAS float*)(lds + OFF_WS) + wid * 64; LAS float* li_l = ws; LAS float* al_l = ws + 32;
  LAS float* xch = (LAS float*)(lds + OFF_XCH) + g4 * (32 * 128);
  const size_t rowbase = (size_t)b * SEQ; const int q0 = qb * 128;
  float m_reg = -1e30f, l_reg = 0.f; f32x16 o[4] = {}; bf16x8 qr[4];
  { const bf16* Qw = Q + (rowbase + q0 + g4 * 32 + r32) * LDQK + h * 128 + c * 64 + hi * 8;
#pragma unroll
    for (int d0 = 0; d0 < 4; ++d0) qr[d0] = *(const GAS bf16x8*)(Qw + d0 * 16); }
  const bf16* Kh = K + rowbase * LDQK + h * 128; const bf16* Vh = V + rowbase * LDQK + h * 128;
  const float nslope = -__builtin_amdgcn_exp2f(-(float)(h + 1)) * 1.4426950408889634f;
  const float kb0 = (float)(4 * hi - (q0 + g4 * 32 + r32));
  const int cbase = c * 128 + hi * 16;
  const int sr = tid >> 4, sc = (tid & 15) * 8, vst0 = v_st(sr, sc), vst1 = v_st(32 + sr, sc);
  const int vb0 = (int)(uintptr_t)V_lds + v_rd_base(lane);
  struct { bf16x8 vs0, vs1, ks0, ks1; } sr_[2];
#define SLOAD(i, k0) do { sr_[i].vs0 = *(const GAS bf16x8*)(&Vh[(size_t)((k0) + sr) * LDQK + sc]); sr_[i].vs1 = *(const GAS bf16x8*)(&Vh[(size_t)((k0) + 32 + sr) * LDQK + sc]); \
    sr_[i].ks0 = *(const GAS bf16x8*)(&Kh[(size_t)((k0) + sr) * LDQK + sc]); sr_[i].ks1 = *(const GAS bf16x8*)(&Kh[(size_t)((k0) + 32 + sr) * LDQK + sc]); } while (0)
#define SWRITE(bb, i) do { *(LAS bf16x8*)(V_lds + (bb) * SHM_V + vst0) = sr_[i].vs0; *(LAS bf16x8*)(V_lds + (bb) * SHM_V + vst1) = sr_[i].vs1; const int kc = sc * 2; \
    *(LAS bf16x8*)(K_lds + (bb) * SHM_K + KSWZ(sr, kc)) = sr_[i].ks0; *(LAS bf16x8*)(K_lds + (bb) * SHM_K + KSWZ(32 + sr, kc)) = sr_[i].ks1; } while (0)
#define SWAIT() asm volatile("s_waitcnt vmcnt(4)" ::: "memory")
#define RESC(a) do { if (__any((a) < 1.f)) { if (hi == 0) al_l[r32] = (a); asm volatile("s_waitcnt lgkmcnt(0)" ::: "memory"); \
    _Pragma("unroll") for (int d = 0; d < 4; ++d) _Pragma("unroll") for (int r = 0; r < 16; ++r) o[d][r] *= al_l[crow(r, hi)]; } } while (0)
  f32x16 pA0, pA1, pB0, pB1; float mnA, mnB, alA, alB; bf16x8 pa0, pa1, pa2, pa3; constexpr int NT = SEQ / KVBLK;
  constexpr int SE = 0, SO = 1;
  SLOAD(SE, 0); asm volatile("s_waitcnt vmcnt(0)" ::: "memory"); SWRITE(0, SE); __syncthreads();
  qkt(pA0, pA1, K_lds, qr, r32, cbase); partialSM(pA0, pA1, kb0, nslope, m_reg, mnA, alA);
  SLOAD(SO, KVBLK); SLOAD(SE, 2 * KVBLK);
  SWAIT(); SWRITE(1, SO); __syncthreads();
  for (int j = 1; j + 1 < NT; j += 2) {
    SBAR(); qkt(pB0, pB1, K_lds + SHM_K, qr, r32, cbase);
    finishSM(pA0, pA1, alA, l_reg, pa0, pa1, pa2, pa3); SBAR();
    SLOAD(SO, (j + 2) * KVBLK); SBAR();
    pv_d0(o, vb0, pa0, pa1, pa2, pa3); partialSM(pB0, pB1, kb0 + (float)(j * KVBLK), nslope, m_reg, mnB, alB);
    __syncthreads(); SWAIT(); SWRITE(0, SE);
    RESC(alB); __syncthreads();
    SBAR(); qkt(pA0, pA1, K_lds, qr, r32, cbase);
    finishSM(pB0, pB1, alB, l_reg, pa0, pa1, pa2, pa3); SBAR();
    if (j + 3 < NT) SLOAD(SE, (j + 3) * KVBLK); SBAR();
    pv_d0(o, vb0 + SHM_V, pa0, pa1, pa2, pa3); partialSM(pA0, pA1, kb0 + (float)((j + 1) * KVBLK), nslope, m_reg, mnA, alA);
    __syncthreads(); SWAIT(); SWRITE(1, SO);
    RESC(alA); __syncthreads();
  }
  SBAR(); qkt(pB0, pB1, K_lds + SHM_K, qr, r32, cbase);
  finishSM(pA0, pA1, alA, l_reg, pa0, pa1, pa2, pa3); SBAR();
  pv_d0(o, vb0, pa0, pa1, pa2, pa3); partialSM(pB0, pB1, kb0 + (float)((NT - 1) * KVBLK), nslope, m_reg, mnB, alB);
  __syncthreads(); RESC(alB);
  finishSM(pB0, pB1, alB, l_reg, pa0, pa1, pa2, pa3); SBAR();
  pv_d0(o, vb0 + SHM_V, pa0, pa1, pa2, pa3);
  int lane_e = threadIdx.x & 63; asm volatile("" : "+v"(lane_e));
  const int r32e = lane_e & 31, hie = lane_e >> 5;
  if (hie == 0) li_l[r32e] = l_reg; asm volatile("s_waitcnt lgkmcnt(0)" ::: "memory");
  float rli[16];
#pragma unroll
  for (int r = 0; r < 16; ++r) rli[r] = __builtin_amdgcn_rcpf(li_l[crow(r, hie)]);
  if (c == 1) {
#pragma unroll
    for (int r = 0; r < 16; ++r) { const float sc1 = rli[r] * lam;
#pragma unroll
      for (int d0 = 0; d0 < 4; ++d0) xch[crow(r, hie) * 128 + d0 * 32 + r32e] = o[d0][r] * sc1; }
  }
  __syncthreads();
  if (c == 0) {
    float gn[4];
#pragma unroll
    for (int d0 = 0; d0 < 4; ++d0) gn[d0] = gain[d0 * 32 + r32e] * (1.0f - LAMBDA_INIT);
    bf16* Ow = O + (rowbase + q0 + g4 * 32) * LDQK + h * 128;
#pragma unroll
    for (int r = 0; r < 16; ++r) { float x[4]; float ss = 0.f;
#pragma unroll
      for (int d0 = 0; d0 < 4; ++d0) { x[d0] = o[d0][r] * rli[r] - xch[crow(r, hie) * 128 + d0 * 32 + r32e]; ss += x[d0] * x[d0]; }
      ss += __shfl_xor(ss, 1); ss += __shfl_xor(ss, 2); ss += __shfl_xor(ss, 4); ss += __shfl_xor(ss, 8); ss += __shfl_xor(ss, 16);
      const float rstd = 1.0f / sqrtf(ss * (1.f / 128.f) + LN_EPS);
#pragma unroll
      for (int d0 = 0; d0 < 4; ++d0) Ow[(size_t)crow(r, hie) * LDQK + d0 * 32 + r32e] = (bf16)f2bf(x[d0] * rstd * gn[d0]); }
  }
  __syncthreads();
#undef SLOAD
#undef SWRITE
#undef SWAIT
#undef RESC
}
#undef KSWZ
#undef SBAR
}

namespace sgu {
using att::bf16x8; using att::f32x16; using att::u32x4;
constexpr int OFF_V = 0, OFF_ST = 32768, OFF_T = 34816, T_LD = 132, SGU_LDS = OFF_T + 128 * T_LD * 4;
struct Args { const bf16* sv; bf16* u; const float* lnpart; const float *ln_g, *ln_b, *w_s, *b_s; };
__device__ __forceinline__ void sgu_unit(const Args& A, int c, int g, LAS char* lds) {
  const int tid = threadIdx.x, lane = tid & 63, r32 = lane & 31, hi = lane >> 5; const int wid = __builtin_amdgcn_readfirstlane(tid >> 6);
  const int tb = wid & 3, dh = wid >> 2;
  LAS char* V_lds = lds + OFF_V; LAS f32x2* st = (LAS f32x2*)(lds + OFF_ST); LAS float* T = (LAS float*)(lds + OFF_T);
  const size_t row0 = (size_t)c * 128;
  if (tid < 128) { float s1 = 0.f, s2 = 0.f; const GAS f32x4* p = (const GAS f32x4*)(A.lnpart + (row0 + tid) * 32);
#pragma unroll
    for (int q = 0; q < 8; ++q) { const f32x4 t = p[q]; s1 += t.x + t.z; s2 += t.y + t.w; }
    const float mean = s1 * (1.f / SGW), var = fmaxf(s2 * (1.f / SGW) - mean * mean, 0.f);
    st[tid] = (f32x2){mean, 1.0f / sqrtf(var + LN_EPS)}; }
  bf16x8 pa[8];
  { const GAS f32x4* wp = (const GAS f32x4*)(A.w_s + ((size_t)g * 128 + tb * 32 + r32) * 128 + hi * 8);
#pragma unroll
    for (int ks = 0; ks < 8; ++ks) { const f32x4 a = wp[ks * 4], b2 = wp[ks * 4 + 1];
      u32x4 w = {att::cvtpk(a.x, a.y), att::cvtpk(a.z, a.w), att::cvtpk(b2.x, b2.y), att::cvtpk(b2.z, b2.w)}; pa[ks] = __builtin_bit_cast(bf16x8, w); } }
  __syncthreads();
  { const int sr = tid >> 4, sc = (tid & 15) * 8; const int ch = g * 128 + sc;
    const f32x4 g0 = *(const GAS f32x4*)(A.ln_g + ch), g1 = *(const GAS f32x4*)(A.ln_g + ch + 4), b0 = *(const GAS f32x4*)(A.ln_b + ch), b1 = *(const GAS f32x4*)(A.ln_b + ch + 4);
#pragma unroll
    for (int i = 0; i < 4; ++i) { const int s = sr + 32 * i; const f32x2 ms = st[s];
      const v4u w = *(const GAS v4u*)(A.sv + (row0 + s) * SGW + ch);
      const float x0 = (bflo(w.x) - ms.x) * ms.y * g0.x + b0.x, x1 = (bfhi(w.x) - ms.x) * ms.y * g0.y + b0.y, x2 = (bflo(w.y) - ms.x) * ms.y * g0.z + b0.z, x3 = (bfhi(w.y) - ms.x) * ms.y * g0.w + b0.w;
      const float x4 = (bflo(w.z) - ms.x) * ms.y * g1.x + b1.x, x5 = (bfhi(w.z) - ms.x) * ms.y * g1.y + b1.y, x6 = (bflo(w.w) - ms.x) * ms.y * g1.z + b1.z, x7 = (bfhi(w.w) - ms.x) * ms.y * g1.w + b1.w;
      u32x4 o = {att::cvtpk(x0, x1), att::cvtpk(x2, x3), att::cvtpk(x4, x5), att::cvtpk(x6, x7)};
      *(LAS u32x4*)(V_lds + (i >> 1) * att::SHM_V + att::v_st((i & 1) * 32 + sr, sc)) = o; } }
  __syncthreads();
  f32x16 acc[2] = {};
  const int vb0 = (int)(uintptr_t)V_lds + att::v_rd_base(lane);
  if (dh == 0) {
    att::pv_one<0>(acc[0], vb0, pa[0], pa[1], pa[2], pa[3]); att::pv_one<1>(acc[1], vb0, pa[0], pa[1], pa[2], pa[3]);
    att::pv_one<0>(acc[0], vb0 + att::SHM_V, pa[4], pa[5], pa[6], pa[7]); att::pv_one<1>(acc[1], vb0 + att::SHM_V, pa[4], pa[5], pa[6], pa[7]);
  } else {
    att::pv_one<2>(acc[0], vb0, pa[0], pa[1], pa[2], pa[3]); att::pv_one<3>(acc[1], vb0, pa[0], pa[1], pa[2], pa[3]);
    att::pv_one<2>(acc[0], vb0 + att::SHM_V, pa[4], pa[5], pa[6], pa[7]); att::pv_one<3>(acc[1], vb0 + att::SHM_V, pa[4], pa[5], pa[6], pa[7]);
  }
#pragma unroll
  for (int r = 0; r < 16; ++r) { const int t = tb * 32 + att::crow(r, hi); const float bs = A.b_s[g * 128 + t];
#pragma unroll
    for (int k = 0; k < 2; ++k) T[t * T_LD + (2 * dh + k) * 32 + r32] = acc[k][r] + bs; }
  __syncthreads();
  { const int t = tid >> 2, dq = (tid & 3) * 32; GAS v4u* up = (GAS v4u*)(A.u + (row0 + t) * SGW + g * 128 + dq); const LAS f32x4* tp = (const LAS f32x4*)(T + t * T_LD + dq);
#pragma unroll
    for (int q = 0; q < 4; ++q) { const v4u w = up[q]; const f32x4 m0 = tp[2 * q], m1 = tp[2 * q + 1]; v4u o;
      o.x = att::cvtpk(bflo(w.x) * m0.x, bfhi(w.x) * m0.y); o.y = att::cvtpk(bflo(w.y) * m0.z, bfhi(w.y) * m0.w);
      o.z = att::cvtpk(bflo(w.z) * m1.x, bfhi(w.z) * m1.y); o.w = att::cvtpk(bflo(w.w) * m1.z, bfhi(w.w) * m1.w);
      up[q] = o; } }
  __syncthreads();
}
}

struct Args { const float* in[21]; float* out; unsigned char* ws; int ph_lo, ph_hi; };
constexpr int N_PHASES = 9;

__global__ void __launch_bounds__(NWAVES * 64, 2) fwd_kernel(Args args) {
    extern __shared__ __attribute__((aligned(16))) unsigned char lds_raw[];
    Frame F;
    F.lds = (LAS unsigned char*)lds_raw;
    F.tid = threadIdx.x; F.lane = F.tid & 63; F.wave = __builtin_amdgcn_readfirstlane(F.tid >> 6);
    F.G = gridDim.x; { const int bx = blockIdx.x; F.vcu = (F.G % 8 == 0) ? (bx % 8) * (F.G / 8) + bx / 8 : bx; }
    unsigned char* ws = args.ws;
    const float* x = args.in[0];
    bf16* XB = (bf16*)(ws + WS_XB); bf16* QB = (bf16*)(ws + WS_Q); bf16* KB = (bf16*)(ws + WS_K); bf16* VB = (bf16*)(ws + WS_V); bf16* UB = (bf16*)(ws + WS_U); bf16* SVB = (bf16*)(ws + WS_SV);
    bf16* GATES = (bf16*)(ws + WS_GATES); bf16* MERGED = (bf16*)(ws + WS_MERGED); bf16* HB = (bf16*)(ws + WS_H);
    bf16* WIN = (bf16*)(ws + WS_WIN); bf16* WBA = (bf16*)(ws + WS_WBA); bf16* WBS = (bf16*)(ws + WS_WBS); bf16* WO = (bf16*)(ws + WS_WO); bf16* WUP = (bf16*)(ws + WS_WUP); bf16* WDN = (bf16*)(ws + WS_WDN);
    float* LNPART = (float*)(ws + WS_LNPART);
    float* out = args.out;
    const int lo = args.ph_lo, hi = args.ph_hi;
#define IN(k) (lo <= (k) && (k) < hi)
#define SEAM(k) do { if (IN(k) && IN((k) + 1)) { cg::this_grid().sync(); } } while (0)

#if DBG_ZERO & 1
    for (int u = F.tid; u < LDS_BYTES / 4; u += 512) ((LAS unsigned*)F.lds)[u] = 0u;
    __syncthreads();
#endif
    if (IN(0)) {
#if DBG_ZERO & 2
        { const size_t n16 = (WS_END - WS_Q) / 16, nthr = (size_t)F.G * 512; v4u z = {0u, 0u, 0u, 0u};
          for (size_t i = (size_t)F.vcu * 512 + F.tid; i < n16; i += nthr) *((GAS v4u*)(ws + WS_Q) + i) = z; }
#endif
        P0Args A{x, args.in[1], args.in[12], args.in[13], args.in[14], args.in[17], args.in[18], XB, WIN, WBA, WBS, WO, WUP, WDN};
        p0_prologue(F, A);
    }
    SEAM(0);
    if (IN(1)) {
        pg8::Gemm g{XB, WIN, XB, WIN, NTOK, INW, DM}; pg8::StaticOrder S; S.init(NTOK, INW, F.G, (int)blockIdx.x);
        pg8::EpiInProj E{QB, GATES, args.in[11], LNPART};
        pg8::gemm_phase<pg8::EpiInProj, pg8::StaticOrder, DBG_ALIGN, DBG_SP2>(F.lds, g, S, E);
    }
    SEAM(1);
    if (IN(2)) {
        { SguArgs A{SVB, UB, LNPART, args.in[7], args.in[8], args.in[9], args.in[10]};
          for (int it = F.vcu; it < 128 * 8; it += F.G) {
#if SGU_NAIVE
              sgu_unit_naive(F, A, it >> 3, it & 7);
#else
              { const sgu::Args B{A.sv, A.u, A.lnpart, A.ln_g, A.ln_b, A.w_s, A.b_s}; sgu::sgu_unit(B, it >> 3, it & 7, (LAS char*)F.lds); }
#endif
          } }
        { AttnArgs A{QB, KB, VB, QB, args.in[6], compute_lam(args.in[2], args.in[3], args.in[4], args.in[5], F.lane)};
          for (int it = F.vcu; it < NB * NH * 32; it += F.G) { const int bh = it >> 5, qb = it & 31;
#if ATTN_NAIVE
              attn_unit_naive(F, A, bh >> 3, bh & 7, qb);
#else
              att::attn_unit(bh >> 3, bh & 7, qb, A.q, A.k, A.v, A.o, A.gain, A.lam, (LAS char*)F.lds);
#endif
          } }
    }
    SEAM(2);
    if (IN(3)) {
        pg8::Gemm g{QB, WBA, UB, WBS, NTOK, DM, 1024}; pg8::TwoPartOrder S; S.init(NTOK, DM, F.G, (int)blockIdx.x);
        pg8::EpiMerge E{GATES, out, MERGED};
        pg8::gemm_phase<pg8::EpiMerge, pg8::TwoPartOrder, true, true>(F.lds, g, S, E);
    }
    SEAM(3);
    if (IN(4)) {
        pg8::Gemm g{MERGED, WO, MERGED, WO, NTOK, DM, DM}; pg8::StaticOrder S; S.init(NTOK, DM, F.G, (int)blockIdx.x);
        pg8::EpiResid E{x, out, DN_ALPHA};
        pg8::gemm_phase<pg8::EpiResid, pg8::StaticOrder, true, true>(F.lds, g, S, E);
    }
    SEAM(4);
    if (IN(5)) ln_rows(F, out, out, XB, args.in[15], args.in[16]);
    SEAM(5);
    if (IN(6)) {
        pg8::Gemm g{XB, WUP, XB, WUP, NTOK, DFF, DM}; pg8::StaticOrder S; S.init(NTOK, DFF, F.G, (int)blockIdx.x);
        pg8::EpiRelu2 E{HB};
        pg8::gemm_phase<pg8::EpiRelu2, pg8::StaticOrder, true, true>(F.lds, g, S, E);
    }
    SEAM(6);
    if (IN(7)) {
        pg8::Gemm g{HB, WDN, HB, WDN, NTOK, DM, DFF}; pg8::StaticOrder S; S.init(NTOK, DM, F.G, (int)blockIdx.x);
        pg8::EpiResid E{out, out, DN_ALPHA};
        pg8::gemm_phase<pg8::EpiResid, pg8::StaticOrder, true, true>(F.lds, g, S, E);
    }
    SEAM(7);
    if (IN(8)) ln_rows(F, out, out, nullptr, args.in[19], args.in[20]);

#if DBG_CUT >= 0
#if MK_N_LAUNCHES == 1
    cg::this_grid().sync();
    {
        const int cut = DBG_CUT;
#else
    if (lo >= 100) {
        const int cut = lo - 100;
#endif
        const size_t n = (size_t)NTOK * DM, nthr = (size_t)F.G * 512;
        for (size_t i = (size_t)F.vcu * 512 + F.tid; i < n; i += nthr) {
            const size_t r = i / DM; const int c = (int)(i % DM); float v = 0.f;
            auto bfv = [](const bf16* p) { return __uint_as_float((unsigned)(*p) << 16); };
            if (cut == 0) { v = bfv(XB + i) + bfv(WIN + (r % 9216) * 2048 + c) + bfv(WUP + (r % 8192) * 2048 + c) + bfv(WDN + (r % 2048) * 8192 + c + 2048 * ((r >> 11) & 3)) + bfv(WO + (r % 2048) * 2048 + c) + bfv(WBA + (r % 2048) * 1024 + (c & 1023)) + bfv(WBS + (r % 2048) * 1024 + (c & 1023)); }
            else if (cut == 1) { for (int k = 0; k < 3; ++k) { const int cc = c + 2048 * k; if (cc < 5120) v += bfv(QB + (size_t)(cc >> 10) * ((size_t)NTOK * 1024) + r * 1024 + (cc & 1023)); }
                            v += bfv(GATES + r * 4096 + c) + bfv(GATES + r * 4096 + 2048 + c); }
            else if (cut == 2) { v = (c < 1024) ? bfv(QB + r * 1024 + c) : bfv(UB + r * 1024 + (c - 1024)); }
            else if (cut == 3) { v = bfv(MERGED + r * 2048 + c); }
            else if (cut == 6) { for (int k = 0; k < 4; ++k) v += bfv(HB + r * 8192 + c + 2048 * k); }
            else continue;
            out[i] = v;
        }
    }
#endif
#undef IN
#undef SEAM
}

extern "C" void kernel_launch(void* const* d_in, const int* in_sizes, int n_in, void* d_out, int out_size, void* d_ws, size_t ws_size, hipStream_t stream) {
    static int grid = 0;
    if (grid == 0) {
        if (n_in != 21 || in_sizes[0] != NTOK * DM || out_size != NTOK * DM || ws_size < WS_END) {
            fprintf(stderr, "kernel_launch: unexpected shapes: n_in %d in0 %d out %d ws %zu (need >= %zu)\n", n_in, n_in > 0 ? in_sizes[0] : -1, out_size, ws_size, (size_t)WS_END); grid = -1; return; }
        int dev = 0, cus = 0, per_cu = 0;
        if (hipGetDevice(&dev) != hipSuccess || hipDeviceGetAttribute(&cus, hipDeviceAttributeMultiprocessorCount, dev) != hipSuccess) { grid = -1; return; }
        if (hipFuncSetAttribute((const void*)fwd_kernel, hipFuncAttributeMaxDynamicSharedMemorySize, LDS_BYTES) != hipSuccess) { fprintf(stderr, "kernel_launch: hipFuncSetAttribute failed\n"); grid = -1; return; }
        if (hipOccupancyMaxActiveBlocksPerMultiprocessor(&per_cu, (const void*)fwd_kernel, NWAVES * 64, LDS_BYTES) != hipSuccess || per_cu < 1) { fprintf(stderr, "kernel_launch: occupancy query says %d blocks per CU\n", per_cu); per_cu = 1; }
        (void)hipGetLastError();
        grid = cus;
        fprintf(stderr, "kernel_launch: %d CUs, occupancy query %d per CU, grid %d\n", cus, per_cu, grid);
    }
    if (grid < 0) return;
    Args a{};
    for (int i = 0; i < 21; ++i) a.in[i] = (const float*)d_in[i];
    a.out = (float*)d_out; a.ws = (unsigned char*)d_ws;
#if MK_N_LAUNCHES == 1
    a.ph_lo = 0; a.ph_hi = (DBG_CUT >= 0) ? DBG_CUT + 1 : N_PHASES;
    void* kargs[] = {&a};
    hipError_t e = hipLaunchCooperativeKernel((const void*)fwd_kernel, dim3(grid), dim3(NWAVES * 64), kargs, LDS_BYTES, stream);
    if (e != hipSuccess) fprintf(stderr, "kernel_launch: cooperative launch failed: %s (grid %d)\n", hipGetErrorString(e), grid);
#else
#if DBG_CUT >= 0
    for (int p = 0; p <= DBG_CUT; ++p) { a.ph_lo = p; a.ph_hi = p + 1; hipLaunchKernelGGL(fwd_kernel, dim3(grid), dim3(NWAVES * 64), LDS_BYTES, stream, a); }
    a.ph_lo = 100 + DBG_CUT; a.ph_hi = 100 + DBG_CUT; hipLaunchKernelGGL(fwd_kernel, dim3(grid), dim3(NWAVES * 64), LDS_BYTES, stream, a);
#else
    for (int p = 0; p < N_PHASES; ++p) {
        a.ph_lo = p; a.ph_hi = p + 1;
        hipLaunchKernelGGL(fwd_kernel, dim3(grid), dim3(NWAVES * 64), LDS_BYTES, stream, a);
    }
#endif
    const hipError_t le = hipPeekAtLastError();
    if (le != hipSuccess) fprintf(stderr, "kernel_launch: launch failed: %s\n", hipGetErrorName(le));
#endif
}
```

```cpp
#include <hip/hip_runtime.h>
#include <hip/hip_cooperative_groups.h>
#include <cstdio>
#include <cstdint>
namespace cg = cooperative_groups;

#ifndef MK_N_LAUNCHES
#define MK_N_LAUNCHES 1
#endif
#ifndef ATTN_NAIVE
#define ATTN_NAIVE 0
#endif
#ifndef SGU_NAIVE
#define SGU_NAIVE 0
#endif

#ifndef DBG_CUT
#define DBG_CUT -1
#endif

#ifndef DBG_ZERO
#define DBG_ZERO 0
#endif

#ifndef DBG_PLAIN
#define DBG_PLAIN 0
#endif
#ifndef DBG_SP2
#define DBG_SP2 true
#endif
#ifndef DBG_ALIGN
#define DBG_ALIGN true
#endif

#ifndef DBG_T1
#define DBG_T1 12
#endif

#ifndef PROBE_REP
#define PROBE_REP 0
#endif

#ifndef USE_CG_SYNC
#define USE_CG_SYNC 0
#endif

namespace pg8 {
#define PG8_LAS __attribute__((address_space(3)))
typedef unsigned short bf16_t;
typedef short bf16x8 __attribute__((ext_vector_type(8)));
typedef float f32x4 __attribute__((ext_vector_type(4)));
typedef unsigned u32x4 __attribute__((ext_vector_type(4)));
constexpr int BM = 256, BK = 64, HALF = 128, HTB = HALF * BK * 2  , STAGE_BYTES = 8 * HTB, NXCD = 8, WGM = 8;

__host__ __device__ __forceinline__ int lds_byte(int r, int c) { const int st = (r >> 4) * 2 + (c >> 5), rr = r & 15, cc = c & 31, ob = rr * 64 + cc * 2; return st * 1024 + (ob ^ (((ob >> 9) & 1) << 5)); }
__host__ __device__ __forceinline__ void stage_rc(int b, int& R, int& C) { const int st = b / 1024, sb = b % 1024, swz = sb ^ (((sb >> 9) & 1) << 5); R = (st >> 1) * 16 + swz / 64; C = (st & 1) * 32 + (swz % 64) / 2; }
__host__ __device__ __forceinline__ int perm32(int rho) { const int n = rho >> 4, i = rho & 15; return 8 * (i >> 2) + 4 * n + (i & 3); }

struct Unit { int pm, pn, part; };
struct Gemm { const bf16_t* A; const bf16_t* Bt; const bf16_t* A1; const bf16_t* Bt1; int M, N, K; };

struct StaticOrder {
    int nM, nN, nwg, G, c;
    __host__ __device__ void init(int M, int N, int G_, int c_) { nM = M / BM; nN = N / BM; nwg = nM * nN; G = G_; c = c_; }
    __host__ __device__ bool next(int i, Unit& u) const {
        const long L = (long)i * G + c; if (L >= nwg) return false;
        int wgid = (int)L; { const int q = nwg / NXCD, r = nwg % NXCD, xcd = wgid % NXCD, off = wgid / NXCD; wgid = (xcd < r ? xcd * (q + 1) : r * (q + 1) + (xcd - r) * q) + off; }
        const int nig = WGM * nN, gid = wgid / nig, fm = gid * WGM, gsz = (nM - fm) < WGM ? (nM - fm) : WGM;
        u.pm = fm + ((wgid % nig) % gsz); u.pn = (wgid % nig) / gsz; u.part = 0; return true;
    }
    __device__ __forceinline__ void a_ready(const Unit&) const {}
    __device__ __forceinline__ void done(const Unit&) const {}
};

typedef float f32x2_cv __attribute__((ext_vector_type(2))); typedef __bf16 bf16x2_cv __attribute__((ext_vector_type(2)));
__device__ __forceinline__ unsigned cvt_pk_bf16(float lo, float hi) { f32x2_cv v = {lo, hi}; bf16x2_cv b = __builtin_convertvector(v, bf16x2_cv); return __builtin_bit_cast(unsigned, b); }
typedef float f32x2 __attribute__((ext_vector_type(2)));
__device__ __forceinline__ f32x2 gelu_pk(f32x2 v) {
    const f32x2 av = __builtin_elementwise_abs(v), d = av * 0.2316418882f + 1.0f;
    f32x2 t; t.x = __builtin_amdgcn_rcpf(d.x); t.y = __builtin_amdgcn_rcpf(d.y);
    f32x2 q = t * 0.5307027145f + (-0.7265760135f); q = q * t + 0.7107068705f; q = q * t + (-0.142248368f); q = q * t + 0.127414796f; q = q * t;
    const f32x2 s = (v * v) * (-0.72134752044f);
    f32x2 e; e.x = __builtin_amdgcn_exp2f(s.x); e.y = __builtin_amdgcn_exp2f(s.y);
    const f32x2 m = v * (q * e), r = v - m;
    f32x2 o; o.x = v.x < 0.f ? m.x : r.x; o.y = v.y < 0.f ? m.y : r.y; return o;
}

constexpr float kC2 = 0.125f * 1.4426950408889634f;
__device__ __forceinline__ float bf_lo(unsigned w) { return __uint_as_float(w << 16); }
__device__ __forceinline__ float bf_hi(unsigned w) { return __uint_as_float(w & 0xffff0000u); }
__device__ __forceinline__ float sigmoidf_(float z) { return __builtin_amdgcn_rcpf(1.0f + __builtin_amdgcn_exp2f(z * -1.4426950408889634f)); }

struct TwoPartOrder {
    StaticOrder so;
    __host__ __device__ void init(int M, int N, int G_, int c_) { so.init(M, N, G_, c_); }
    __host__ __device__ bool next(int i, Unit& u) const { if (!so.next(i >> 1, u)) return false; u.part = i & 1; return true; }
    __device__ __forceinline__ void a_ready(const Unit&) const {}
    __device__ __forceinline__ void done(const Unit&) const {}
};

struct EpiInProj {
    static constexpr bool PERM = true, AFTER_DRAIN = false;
    bf16_t* qkvuv;
    bf16_t* gates;
    const float* b_gate;
    float* lnpart;
    __device__ __forceinline__ void operator()(const f32x4 (&acc)[2][2][4][2], const Unit& u, int wr, int wc, int fr, int fq) const {
        const int row0 = u.pm * BM + wr * 64 + fr; const int pn = u.pn;
#if DBG_PLAIN
        {
            const int t = pn >> 2;
            bf16_t* base = (pn < 20) ? qkvuv + (size_t)t * ((size_t)16384 * 1024) + (pn & 3) * 256 + wc * 32 + 8 * fq : gates + (pn - 20) * 256 + wc * 32 + 8 * fq;
            const size_t ld = (pn < 20) ? 1024 : 4096;
#pragma unroll
            for (int ai = 0; ai < 2; ++ai)
#pragma unroll
                for (int m = 0; m < 4; ++m) { bf16_t* rowp = base + (size_t)(row0 + ai * HALF + m * 16) * ld;
#pragma unroll
                    for (int bj = 0; bj < 2; ++bj) { const f32x4 v0 = acc[ai][bj][m][0] * 0.5f, v1 = acc[ai][bj][m][1] * 0.5f;
                        u32x4 w; w.x = cvt_pk_bf16(v0[0], v0[1]); w.y = cvt_pk_bf16(v0[2], v0[3]); w.z = cvt_pk_bf16(v1[0], v1[1]); w.w = cvt_pk_bf16(v1[2], v1[3]);
                        *(u32x4*)(rowp + bj * HALF) = w; } }
            return;
        }
#endif
        if (pn < DBG_T1) {
            const int t = pn >> 2; const float sc = (t == 0) ? kC2 : 1.0f;
            bf16_t* base = qkvuv + (size_t)t * ((size_t)16384 * 1024) + (pn & 3) * 256 + wc * 32 + 8 * fq;
#pragma unroll
            for (int ai = 0; ai < 2; ++ai)
#pragma unroll
                for (int m = 0; m < 4; ++m) { bf16_t* rowp = base + (size_t)(row0 + ai * HALF + m * 16) * 1024;
#pragma unroll
                    for (int bj = 0; bj < 2; ++bj) { const f32x4 v0 = acc[ai][bj][m][0] * sc, v1 = acc[ai][bj][m][1] * sc;
                        u32x4 w; w.x = cvt_pk_bf16(v0[0], v0[1]); w.y = cvt_pk_bf16(v0[2], v0[3]); w.z = cvt_pk_bf16(v1[0], v1[1]); w.w = cvt_pk_bf16(v1[2], v1[3]);
                        *(u32x4*)(rowp + bj * HALF) = w; } }
        } else if (pn < 20) {
            const int t = pn >> 2; const bool stats = (t == 4);
            bf16_t* base = qkvuv + (size_t)t * ((size_t)16384 * 1024) + (pn & 3) * 256 + wc * 32 + 8 * fq;
#pragma unroll
            for (int ai = 0; ai < 2; ++ai)
#pragma unroll
                for (int m = 0; m < 4; ++m) { const int row = row0 + ai * HALF + m * 16; bf16_t* rowp = base + (size_t)row * 1024; float s1 = 0.f, s2 = 0.f;
#pragma unroll
                    for (int bj = 0; bj < 2; ++bj) { const f32x4 x0 = acc[ai][bj][m][0], x1 = acc[ai][bj][m][1];
                        const f32x2 a = gelu_pk((f32x2){x0[0], x0[1]}), b = gelu_pk((f32x2){x0[2], x0[3]}), c = gelu_pk((f32x2){x1[0], x1[1]}), d = gelu_pk((f32x2){x1[2], x1[3]});
                        s1 += ((a.x + a.y) + (b.x + b.y)) + ((c.x + c.y) + (d.x + d.y));
                        s2 += ((a.x * a.x + a.y * a.y) + (b.x * b.x + b.y * b.y)) + ((c.x * c.x + c.y * c.y) + (d.x * d.x + d.y * d.y));
                        u32x4 w; w.x = cvt_pk_bf16(a.x, a.y); w.y = cvt_pk_bf16(b.x, b.y); w.z = cvt_pk_bf16(c.x, c.y); w.w = cvt_pk_bf16(d.x, d.y);
                        *(u32x4*)(rowp + bj * HALF) = w; }
                    if (stats) { s1 += __shfl_xor(s1, 16); s1 += __shfl_xor(s1, 32); s2 += __shfl_xor(s2, 16); s2 += __shfl_xor(s2, 32);
                        if (fq == 0) *(f32x2*)(lnpart + ((size_t)row * 16 + (pn - 16) * 4 + wc) * 2) = (f32x2){s1, s2}; } }
        } else {
            const int colg = (pn - 20) * 256 + wc * 32 + 8 * fq;
            f32x4 bv[2][2];
#pragma unroll
            for (int bj = 0; bj < 2; ++bj)
#pragma unroll
                for (int n = 0; n < 2; ++n) bv[bj][n] = *(const f32x4*)(b_gate + colg + bj * HALF + 4 * n);
#pragma unroll
            for (int ai = 0; ai < 2; ++ai)
#pragma unroll
                for (int m = 0; m < 4; ++m) { bf16_t* rowp = gates + (size_t)(row0 + ai * HALF + m * 16) * 4096 + colg;
#pragma unroll
                    for (int bj = 0; bj < 2; ++bj) { const f32x4 z0 = acc[ai][bj][m][0] + bv[bj][0], z1 = acc[ai][bj][m][1] + bv[bj][1];
                        u32x4 w; w.x = cvt_pk_bf16(sigmoidf_(z0[0]), sigmoidf_(z0[1])); w.y = cvt_pk_bf16(sigmoidf_(z0[2]), sigmoidf_(z0[3]));
                        w.z = cvt_pk_bf16(sigmoidf_(z1[0]), sigmoidf_(z1[1])); w.w = cvt_pk_bf16(sigmoidf_(z1[2]), sigmoidf_(z1[3]));
                        *(u32x4*)(rowp + bj * HALF) = w; } }
        }
    }
};

struct EpiMerge {
    static constexpr bool PERM = false, AFTER_DRAIN = false;
    const bf16_t* gates; float* tmp; bf16_t* merged;
    __device__ __forceinline__ void operator()(const f32x4 (&acc)[2][2][4][2], const Unit& u, int wr, int wc, int fr, int fq) const {
        typedef unsigned u32x2v __attribute__((ext_vector_type(2)));
        const int row0 = u.pm * BM + wr * 64 + fr, col0 = u.pn * BM + wc * 32 + 4 * fq; const int part = u.part;
#pragma unroll
        for (int ai = 0; ai < 2; ++ai)
#pragma unroll
            for (int m = 0; m < 4; ++m) { const size_t r = (size_t)(row0 + ai * HALF + m * 16);
#pragma unroll
                for (int bj = 0; bj < 2; ++bj)
#pragma unroll
                    for (int n = 0; n < 2; ++n) { const int c = col0 + bj * HALF + n * 16;
                        const u32x2v gw = *(const u32x2v*)(gates + r * 4096 + part * 2048 + c);
                        const f32x4 g = (f32x4){bf_lo(gw.x), bf_hi(gw.x), bf_lo(gw.y), bf_hi(gw.y)};
                        const f32x4 v = g * acc[ai][bj][m][n];
                        if (part == 0) { *(f32x4*)(tmp + r * 2048 + c) = v; }
                        else { const f32x4 o = *(const f32x4*)(tmp + r * 2048 + c) + v; u32x2v w; w.x = cvt_pk_bf16(o[0], o[1]); w.y = cvt_pk_bf16(o[2], o[3]); *(u32x2v*)(merged + r * 2048 + c) = w; } } }
        if (part == 0) asm volatile("s_waitcnt vmcnt(0)" ::: "memory");
    }
};

struct EpiResid {
    static constexpr bool PERM = false, AFTER_DRAIN = false;
    const float* base; float* out; float alpha;
    __device__ __forceinline__ void operator()(const f32x4 (&acc)[2][2][4][2], const Unit& u, int wr, int wc, int fr, int fq) const {
        const int row0 = u.pm * BM + wr * 64 + fr, col0 = u.pn * BM + wc * 32 + 4 * fq;
#pragma unroll
        for (int ai = 0; ai < 2; ++ai)
#pragma unroll
            for (int m = 0; m < 4; ++m) { const size_t r = (size_t)(row0 + ai * HALF + m * 16);
#pragma unroll
                for (int bj = 0; bj < 2; ++bj)
#pragma unroll
                    for (int n = 0; n < 2; ++n) { const size_t off = r * 2048 + col0 + bj * HALF + n * 16;
                        const f32x4 b = *(const f32x4*)(base + off); *(f32x4*)(out + off) = b * alpha + acc[ai][bj][m][n]; } }
    }
};

struct EpiRelu2 {
    static constexpr bool PERM = true, AFTER_DRAIN = false;
    bf16_t* H;
    __device__ __forceinline__ void operator()(const f32x4 (&acc)[2][2][4][2], const Unit& u, int wr, int wc, int fr, int fq) const {
        const int row0 = u.pm * BM + wr * 64 + fr, col0 = u.pn * BM + wc * 32 + 8 * fq;
#pragma unroll
        for (int ai = 0; ai < 2; ++ai)
#pragma unroll
            for (int m = 0; m < 4; ++m) { bf16_t* rowp = H + (size_t)(row0 + ai * HALF + m * 16) * 8192 + col0;
#pragma unroll
                for (int bj = 0; bj < 2; ++bj) { f32x4 v0 = acc[ai][bj][m][0], v1 = acc[ai][bj][m][1];
#pragma unroll
                    for (int e = 0; e < 4; ++e) { const float a = fmaxf(v0[e], 0.f), b = fmaxf(v1[e], 0.f); v0[e] = a * a; v1[e] = b * b; }
                    u32x4 w; w.x = cvt_pk_bf16(v0[0], v0[1]); w.y = cvt_pk_bf16(v0[2], v0[3]); w.z = cvt_pk_bf16(v1[0], v1[1]); w.w = cvt_pk_bf16(v1[2], v1[3]);
                    *(u32x4*)(rowp + bj * HALF) = w; } }
    }
};

template <class Epi, class Sched, bool ALIGN_EPI = false, bool SP2 = false>
__device__ __forceinline__ void gemm_phase(PG8_LAS unsigned char* lds, const Gemm g, const Sched& S, const Epi& E) {
    const int tid = threadIdx.x, wid = __builtin_amdgcn_readfirstlane(tid >> 6), lane = tid & 63, wr = wid >> 2, wc = wid & 3, fr = lane & 15, fq = lane >> 4;
    const int K = g.K, nt = K / BK;
    unsigned voffA[2], voffB[2];
#pragma unroll
    for (int i = 0; i < 2; ++i) { int R, C; stage_rc(tid * 16 + i * 8192, R, C); const int Rb = Epi::PERM ? ((R & ~31) + perm32(R & 31)) : R;
        voffA[i] = (unsigned)(R * K + C) * 2u; voffB[i] = (unsigned)(Rb * K + C) * 2u; }
    const size_t kstep = (size_t)(BK * 2);
    const size_t hstep = (size_t)HALF * K * 2;
    const size_t tstep = 2 * hstep;
    const unsigned ldsw = (unsigned)wid * 1024u;
    const int aoff = lds_byte(wr * 64 + fr, fq * 8), boff = lds_byte(wc * 32 + fr, fq * 8);
#define PG8_SA(b, h) (((b) * 2 + (h)) * HTB)
#define PG8_SB(b, h) ((4 + (b) * 2 + (h)) * HTB)
#define PG8_STAGE(bufoff, gbase, voff) do { _Pragma("unroll") for (int _i = 0; _i < 2; ++_i) \
        __builtin_amdgcn_global_load_lds((const unsigned*)((const char*)(gbase) + (voff)[_i]), (PG8_LAS unsigned*)(lds + (bufoff) + ldsw + _i * 8192), 16, 0, 0); } while (0)
#define PG8_LDA(dst, b, h) do { _Pragma("unroll") for (int m = 0; m < 4; ++m) _Pragma("unroll") for (int k = 0; k < 2; ++k) dst[m][k] = *(const PG8_LAS bf16x8*)(lds + PG8_SA(b, h) + aoff + m * 2048 + k * 1024); } while (0)
#define PG8_LDB(dst, b, h) do { _Pragma("unroll") for (int n = 0; n < 2; ++n) _Pragma("unroll") for (int k = 0; k < 2; ++k) dst[n][k] = *(const PG8_LAS bf16x8*)(lds + PG8_SB(b, h) + boff + n * 2048 + k * 1024); } while (0)
#define PG8_MMA(ai, bj, At, Bt) do { __builtin_amdgcn_s_setprio(1); _Pragma("unroll") for (int m = 0; m < 4; ++m) _Pragma("unroll") for (int n = 0; n < 2; ++n) _Pragma("unroll") for (int k = 0; k < 2; ++k) \
        acc[ai][bj][m][n] = __builtin_amdgcn_mfma_f32_16x16x32_bf16(Bt[n][k], At[m][k], acc[ai][bj][m][n], 0, 0, 0); __builtin_amdgcn_s_setprio(0); } while (0)
#define PG8_WAIT_V(n) asm volatile("s_waitcnt vmcnt(" #n ")" ::: "memory")
#define PG8_WAIT_L(n) asm volatile("s_waitcnt lgkmcnt(" #n ")" ::: "memory")
#define PG8_BAR __builtin_amdgcn_s_barrier()
#define PG8_SCHED __builtin_amdgcn_sched_barrier(0)
    Unit cur, nxt; int ui = 0;
    if (!S.next(0, cur)) return;
    f32x4 acc[2][2][4][2];
#pragma unroll
    for (int a = 0; a < 2; ++a)
#pragma unroll
        for (int b = 0; b < 2; ++b)
#pragma unroll
            for (int m = 0; m < 4; ++m)
#pragma unroll
                for (int n = 0; n < 2; ++n) acc[a][b][m][n] = (f32x4){0.f, 0.f, 0.f, 0.f};
    bf16x8 At[4][2], B0[2][2], B1[2][2];
    const char* cA = (const char*)(cur.part ? g.A1 : g.A) + (size_t)cur.pm * tstep; const char* cB = (const char*)(cur.part ? g.Bt1 : g.Bt) + (size_t)cur.pn * tstep;
    S.a_ready(cur);
    if constexpr (SP2) {
        PG8_STAGE(PG8_SB(0, 0), cB, voffB); PG8_STAGE(PG8_SB(0, 1), cB + hstep, voffB); PG8_STAGE(PG8_SA(0, 0), cA, voffA); PG8_STAGE(PG8_SA(0, 1), cA + hstep, voffA);
        if (wr == 1) PG8_BAR;
        PG8_WAIT_V(2); PG8_BAR;
        PG8_STAGE(PG8_SB(1, 0), cB + kstep, voffB); PG8_STAGE(PG8_SA(1, 0), cA + kstep, voffA); PG8_STAGE(PG8_SB(1, 1), cB + hstep + kstep, voffB);
        PG8_WAIT_V(6); PG8_BAR;
    } else {
        PG8_STAGE(PG8_SB(0, 0), cB, voffB); PG8_STAGE(PG8_SA(0, 0), cA, voffA); PG8_STAGE(PG8_SB(0, 1), cB + hstep, voffB); PG8_STAGE(PG8_SA(0, 1), cA + hstep, voffA);
        if (wr == 1) PG8_BAR;
        PG8_WAIT_V(4); PG8_BAR;
        PG8_STAGE(PG8_SB(1, 0), cB + kstep, voffB); PG8_STAGE(PG8_SA(1, 0), cA + kstep, voffA); PG8_STAGE(PG8_SB(1, 1), cB + hstep + kstep, voffB);
        PG8_WAIT_V(6); PG8_BAR;
    }
    for (;;) {
        const bool has_next = S.next(ui + 1, nxt);
        const char* nA = has_next ? (const char*)(nxt.part ? g.A1 : g.A) + (size_t)nxt.pm * tstep : cA; const char* nB = has_next ? (const char*)(nxt.part ? g.Bt1 : g.Bt) + (size_t)nxt.pn * tstep : cB;
        for (int t = 0; t < nt; t += 2) {
            const bool last = (t == nt - 2);
            const char* a1 = cA + (size_t)(t + 1) * kstep;
            const char* a2 = last ? nA : cA + (size_t)(t + 2) * kstep; const char* b2 = last ? nB : cB + (size_t)(t + 2) * kstep;
            const char* a3 = a2 + kstep; const char* b3 = b2 + kstep;
            if (last && has_next) S.a_ready(nxt);
            if constexpr (SP2) {
            PG8_LDB(B0, 0, 0); PG8_LDB(B1, 0, 1); PG8_SCHED; PG8_LDA(At, 0, 0); PG8_STAGE(PG8_SA(1, 1), a1 + hstep, voffA);
            PG8_WAIT_V(8); PG8_WAIT_L(0); PG8_BAR; PG8_MMA(0, 0, At, B0); PG8_MMA(0, 1, At, B1); PG8_BAR; PG8_SCHED;
            PG8_LDA(At, 0, 1); PG8_STAGE(PG8_SB(0, 0), b2, voffB); PG8_STAGE(PG8_SB(0, 1), b2 + hstep, voffB); PG8_STAGE(PG8_SA(0, 0), a2, voffA);
            PG8_WAIT_V(8); PG8_WAIT_L(0); PG8_BAR; PG8_MMA(1, 0, At, B0); PG8_MMA(1, 1, At, B1); PG8_BAR; PG8_SCHED;
            PG8_LDB(B0, 1, 0); PG8_LDB(B1, 1, 1); PG8_SCHED; PG8_LDA(At, 1, 0); PG8_STAGE(PG8_SA(0, 1), a2 + hstep, voffA);
            PG8_WAIT_V(8); PG8_WAIT_L(0); PG8_BAR; PG8_MMA(0, 0, At, B0); PG8_MMA(0, 1, At, B1); PG8_BAR; PG8_SCHED;
            PG8_LDA(At, 1, 1); PG8_STAGE(PG8_SB(1, 0), b3, voffB); PG8_STAGE(PG8_SB(1, 1), b3 + hstep, voffB); PG8_STAGE(PG8_SA(1, 0), a3, voffA);
            PG8_WAIT_V(8); PG8_WAIT_L(0); PG8_BAR; PG8_MMA(1, 0, At, B0); PG8_MMA(1, 1, At, B1); PG8_BAR; PG8_SCHED;
            } else {
            PG8_LDB(B0, 0, 0); PG8_SCHED; PG8_LDA(At, 0, 0); PG8_STAGE(PG8_SA(1, 1), a1 + hstep, voffA);
            PG8_WAIT_L(8); PG8_BAR; PG8_WAIT_L(0); PG8_MMA(0, 0, At, B0); PG8_BAR; PG8_SCHED;
            PG8_LDB(B1, 0, 1); PG8_STAGE(PG8_SB(0, 0), b2, voffB);
            PG8_BAR; PG8_WAIT_L(0); PG8_MMA(0, 1, At, B1); PG8_BAR;
            PG8_LDA(At, 0, 1); PG8_STAGE(PG8_SA(0, 0), a2, voffA);
            PG8_BAR; PG8_WAIT_L(0); PG8_MMA(1, 0, At, B0); PG8_BAR; PG8_SCHED;
            PG8_STAGE(PG8_SB(0, 1), b2 + hstep, voffB);
            PG8_WAIT_V(6); PG8_BAR; PG8_MMA(1, 1, At, B1); PG8_BAR;
            PG8_LDB(B0, 1, 0); PG8_SCHED; PG8_LDA(At, 1, 0); PG8_STAGE(PG8_SA(0, 1), a2 + hstep, voffA);
            PG8_WAIT_L(8); PG8_BAR; PG8_WAIT_L(0); PG8_MMA(0, 0, At, B0); PG8_BAR; PG8_SCHED;
            PG8_LDB(B1, 1, 1); PG8_STAGE(PG8_SB(1, 0), b3, voffB);
            PG8_BAR; PG8_WAIT_L(0); PG8_MMA(0, 1, At, B1); PG8_BAR;
            PG8_LDA(At, 1, 1); PG8_STAGE(PG8_SA(1, 0), a3, voffA);
            PG8_BAR; PG8_WAIT_L(0); PG8_MMA(1, 0, At, B0); PG8_BAR; PG8_SCHED;
            PG8_STAGE(PG8_SB(1, 1), b3 + hstep, voffB);
            PG8_WAIT_V(6); PG8_BAR; PG8_MMA(1, 1, At, B1); PG8_BAR;
            }
        }
        if constexpr (ALIGN_EPI) { if (wr == 0) PG8_BAR; }
        if constexpr (!Epi::AFTER_DRAIN) { E(acc, cur, wr, wc, fr, fq); S.done(cur); }
        if (!has_next) break;
#pragma unroll
        for (int a = 0; a < 2; ++a)
#pragma unroll
            for (int b = 0; b < 2; ++b)
#pragma unroll
                for (int m = 0; m < 4; ++m)
#pragma unroll
                    for (int n = 0; n < 2; ++n) acc[a][b][m][n] = (f32x4){0.f, 0.f, 0.f, 0.f};
        cur = nxt; cA = nA; cB = nB; ++ui;
        if constexpr (ALIGN_EPI) { if (wr == 1) PG8_BAR; }
    }
    PG8_WAIT_V(0);
    if constexpr (!ALIGN_EPI) { if (wr == 0) PG8_BAR; }
    PG8_BAR;
    if constexpr (Epi::AFTER_DRAIN) { E.fused(acc, cur, wr, wc, fr, fq, lds, wid, lane); S.done(cur); }
#undef PG8_SA
#undef PG8_SB
#undef PG8_STAGE
#undef PG8_LDA
#undef PG8_LDB
#undef PG8_MMA
#undef PG8_WAIT_V
#undef PG8_WAIT_L
#undef PG8_BAR
#undef PG8_SCHED
}
}

#define GAS __attribute__((address_space(1)))
#define LAS __attribute__((address_space(3)))
typedef unsigned short bf16;
typedef unsigned v4u __attribute__((ext_vector_type(4)));
typedef unsigned v2u __attribute__((ext_vector_type(2)));
typedef float f32x4 __attribute__((ext_vector_type(4)));
typedef float f32x2 __attribute__((ext_vector_type(2)));
typedef short bf16x8 __attribute__((ext_vector_type(8)));

constexpr int NB = 4, SEQ = 4096, NTOK = NB * SEQ, DM = 2048, INW = 9216, NH = 8, QKW = 1024, SGW = 1024, DFF = 8192;
constexpr float LN_EPS = 1e-5f;
constexpr float DN_ALPHA = 1.189207115002721f;
constexpr float LAMBDA_INIT = 0.2f;
constexpr int NWAVES = 8;

constexpr size_t MiB = 1u << 20;
constexpr size_t WS_CTL = 0, CTL_ZERO_BYTES = 1 * MiB;
constexpr size_t WS_LNPART = 2 * MiB;
constexpr size_t WS_WIN = 4 * MiB;
constexpr size_t WS_WBA = 40 * MiB;
constexpr size_t WS_WBS = 44 * MiB;
constexpr size_t WS_WO = 48 * MiB;
constexpr size_t WS_WUP = 56 * MiB;
constexpr size_t WS_WDN = 88 * MiB;
constexpr size_t WS_XB = 120 * MiB;
constexpr size_t WS_Q = 184 * MiB, WS_K = 216 * MiB, WS_V = 248 * MiB, WS_U = 280 * MiB, WS_SV = 312 * MiB;
constexpr size_t WS_GATES = 344 * MiB;
constexpr size_t WS_MERGED = WS_K;
constexpr size_t WS_H = WS_Q;
constexpr size_t WS_END = 472 * MiB;
static_assert(WS_H + (size_t)NTOK * DFF * 2 <= WS_END && WS_GATES + (size_t)NTOK * 4096 * 2 == WS_END, "d_ws map");

constexpr int LDS_BYTES = 147456;

__device__ __forceinline__ unsigned f2bf(float f) { unsigned u = __builtin_bit_cast(unsigned, f); return (u + 0x7fffu + ((u >> 16) & 1u)) >> 16; }
__device__ __forceinline__ unsigned pk2(float lo, float hi) { return f2bf(lo) | (f2bf(hi) << 16); }
__device__ __forceinline__ float bflo(unsigned w) { return __uint_as_float(w << 16); }
__device__ __forceinline__ float bfhi(unsigned w) { return __uint_as_float(w & 0xffff0000u); }
#define LDS_WAIT() asm volatile("s_waitcnt lgkmcnt(0)" ::: "memory")


typedef GAS unsigned gu32;
#define RLX_AGENT __ATOMIC_RELAXED, __HIP_MEMORY_SCOPE_AGENT
constexpr int CW_BAR = 4096;
constexpr int MISC_OFF = 146432;
#define XB_TMO      128
#define XB_XCNT(j)  (256  + 64 * (j))
#define XB_XSUB(j)  (1280 + 64 * (j))
#define XB_XGEN(j)  (2304 + 64 * (j))
#define XB_TOP      3328
#define XB_TOPGEN   3392
#define XCD_BAR_WORDS 3456
#define XB_SPIN_CAP (1u << 18)

__device__ __forceinline__ unsigned xb_ld(unsigned* p)              { return __hip_atomic_load(p, __ATOMIC_RELAXED, __HIP_MEMORY_SCOPE_AGENT); }
__device__ __forceinline__ unsigned xb_add(unsigned* p, unsigned v) { return __hip_atomic_fetch_add(p, v, __ATOMIC_RELAXED, __HIP_MEMORY_SCOPE_AGENT); }
__device__ __forceinline__ unsigned xb_xcc_id() { return (unsigned)__builtin_amdgcn_s_getreg((3 << 11) | 20) & 0xFu; }
#define XB_SPIN(cond, bar) do { unsigned _sp = 0; while (cond) { __builtin_amdgcn_s_sleep(1); \
    if ((++_sp & 255u) == 0u) { if (xb_ld(&(bar)[XB_TMO])) break; if (_sp > XB_SPIN_CAP) { atomicAdd(&(bar)[XB_TMO], 1u); break; } } } } while (0)

struct XcdBarrier {
    unsigned* bar; unsigned x;
    volatile LAS unsigned* st;
};

__device__ __forceinline__ XcdBarrier xcd_barrier_post(unsigned* bar, volatile LAS unsigned* st) {
    XcdBarrier b; b.bar = bar; b.x = xb_xcc_id(); b.st = st;
    if (threadIdx.x == 0) (void)xb_add(&bar[XB_XCNT(b.x)], 1u);
    return b;
}
__device__ __forceinline__ void xcd_barrier_complete(unsigned* bar, unsigned x, unsigned& nloc, unsigned& nx) {
    const unsigned G = gridDim.x * gridDim.y * gridDim.z;
    unsigned sum, cnt, mine, sp = 0u;
    for (;;) {
        sum = 0u; cnt = 0u; mine = 0u;
#pragma unroll
        for (unsigned j = 0; j < 16; ++j) { const unsigned c = xb_ld(&bar[XB_XCNT(j)]); sum += c; cnt += (c > 0u) ? 1u : 0u; mine = (j == x) ? c : mine; }
        if (sum == G) break;
        __builtin_amdgcn_s_sleep(1);
        if ((++sp & 255u) == 0u) { if (xb_ld(&bar[XB_TMO])) break; if (sp > XB_SPIN_CAP) { atomicAdd(&bar[XB_TMO], 1u); break; } }
    }
    nloc = mine > 0u ? mine : 1u; nx = cnt > 0u ? cnt : 1u;
}

__device__ __forceinline__ void xcd_barrier(const XcdBarrier& b) {
    asm volatile("s_waitcnt vmcnt(0)" ::: "memory");
    __syncthreads();
    if (threadIdx.x == 0) {
        unsigned* bar = b.bar;
        __builtin_amdgcn_s_waitcnt(0);
        unsigned nloc = b.st[0], nx = b.st[1];
        if (nloc == 0u) { xcd_barrier_complete(bar, b.x, nloc, nx); b.st[0] = nloc; b.st[1] = nx; }
        const unsigned old = xb_add(&bar[XB_XSUB(b.x)], 1u);
        const unsigned gen = old / nloc;
        if (old + 1u == (gen + 1u) * nloc) {
            __builtin_amdgcn_fence(__ATOMIC_RELEASE, "agent");
            asm volatile("s_waitcnt vmcnt(0)" ::: "memory");
            const unsigned og = xb_add(&bar[XB_TOP], 1u);
            const unsigned tg = og / nx;
            if (og + 1u == (tg + 1u) * nx) xb_add(&bar[XB_TOPGEN], 1u);
            else XB_SPIN(xb_ld(&bar[XB_TOPGEN]) == tg, bar);
            __builtin_amdgcn_fence(__ATOMIC_ACQUIRE, "agent");
            xb_add(&bar[XB_XGEN(b.x)], 1u);
            asm volatile("s_waitcnt vmcnt(0)" ::: "memory");
        } else {
            XB_SPIN(xb_ld(&bar[XB_XGEN(b.x)]) == gen, bar);
            __builtin_amdgcn_fence(__ATOMIC_ACQUIRE, "agent");
            asm volatile("s_waitcnt vmcnt(0)" ::: "memory");
        }
    }
    __syncthreads();
}

struct Frame {
    LAS unsigned char* lds;
    int tid, lane, wave, vcu, G;
};

__device__ __forceinline__ float wave_sum(float v) {
#pragma unroll
    for (int o = 1; o < 64; o <<= 1) v += __shfl_xor(v, o);
    return v;
}

__device__ __forceinline__ void p0_transpose_item(const float* W, int K, int N, bf16* WT, LAS float* scr, int item, int lane) {
    const int nblk = N / 32, kb = item / nblk, nb = item % nblk, k0 = 64 * kb, n0 = 32 * nb;
#pragma unroll 8
    for (int i = 0; i < 32; ++i) { const int kk = 2 * i + (lane >> 5); scr[kk * 33 + (lane & 31)] = W[(size_t)(k0 + kk) * N + n0 + (lane & 31)]; }
    LDS_WAIT(); asm volatile("" ::: "memory");
    const int c = lane & 7;
#pragma unroll
    for (int j = 0; j < 4; ++j) { const int n = (lane >> 3) + 8 * j; const LAS float* s = scr + (8 * c) * 33 + n;
        v4u o; o.x = pk2(s[0 * 33], s[1 * 33]); o.y = pk2(s[2 * 33], s[3 * 33]); o.z = pk2(s[4 * 33], s[5 * 33]); o.w = pk2(s[6 * 33], s[7 * 33]);
        *(GAS v4u*)(WT + (size_t)(n0 + n) * K + k0 + 8 * c) = o; }
    LDS_WAIT(); asm volatile("" ::: "memory");
}

struct P0Args { const float *x, *w_in, *w_ba, *w_bs, *w_o, *w_up, *w_dn; bf16 *xb, *win_t, *wba_t, *wbs_t, *wo_t, *wup_t, *wdn_t; };
__device__ __forceinline__ void p0_prologue(const Frame& F, const P0Args& A) {
    LAS float* scr = (LAS float*)(F.lds + F.wave * 16384);
    const int gw = F.vcu * NWAVES + F.wave, NGW = F.G * NWAVES;
    constexpr int I_IN = (DM / 64) * (INW / 32), I_BA = (1024 / 64) * (DM / 32), I_O = (DM / 64) * (DM / 32), I_UP = (DM / 64) * (DFF / 32), I_DN = (DFF / 64) * (DM / 32);
    constexpr int NITEMS = I_IN + 2 * I_BA + I_O + I_UP + I_DN;
    for (int it = gw; it < NITEMS; it += NGW) {
        int r = it;
        if (r < I_IN) { p0_transpose_item(A.w_in, DM, INW, A.win_t, scr, r, F.lane); continue; } r -= I_IN;
        if (r < I_BA) { p0_transpose_item(A.w_ba, 1024, DM, A.wba_t, scr, r, F.lane); continue; } r -= I_BA;
        if (r < I_BA) { p0_transpose_item(A.w_bs, 1024, DM, A.wbs_t, scr, r, F.lane); continue; } r -= I_BA;
        if (r < I_O) { p0_transpose_item(A.w_o, DM, DM, A.wo_t, scr, r, F.lane); continue; } r -= I_O;
        if (r < I_UP) { p0_transpose_item(A.w_up, DM, DFF, A.wup_t, scr, r, F.lane); continue; } r -= I_UP;
        p0_transpose_item(A.w_dn, DFF, DM, A.wdn_t, scr, r, F.lane);
    }
    const size_t n8 = (size_t)NTOK * DM / 8, nthr = (size_t)F.G * 512;
    for (size_t i = (size_t)F.vcu * 512 + F.tid; i < n8; i += nthr) {
        const f32x4 a = *(const GAS f32x4*)(A.x + i * 8), b = *(const GAS f32x4*)(A.x + i * 8 + 4);
        v4u o; o.x = pk2(a.x, a.y); o.y = pk2(a.z, a.w); o.z = pk2(b.x, b.y); o.w = pk2(b.z, b.w);
        *(GAS v4u*)(A.xb + i * 8) = o;
    }
}

__device__ __forceinline__ void ln_rows(const Frame& F, const float* in, float* outf, bf16* outb, const float* g, const float* b) {
    const int gw = F.vcu * NWAVES + F.wave, NGW = F.G * NWAVES;
    for (int m = gw; m < NTOK; m += NGW) {
        const GAS f32x4* xr = (const GAS f32x4*)(in + (size_t)m * DM) + F.lane;
        f32x4 v[8]; float s = 0.f;
#pragma unroll
        for (int j = 0; j < 8; ++j) { v[j] = xr[64 * j]; s += (v[j].x + v[j].y) + (v[j].z + v[j].w); }
        const float mean = wave_sum(s) * (1.f / DM); float s2 = 0.f;
#pragma unroll
        for (int j = 0; j < 8; ++j) { v[j] = v[j] - mean; s2 += (v[j].x * v[j].x + v[j].y * v[j].y) + (v[j].z * v[j].z + v[j].w * v[j].w); }
        const float rstd = 1.0f / sqrtf(wave_sum(s2) * (1.f / DM) + LN_EPS);
#pragma unroll
        for (int j = 0; j < 8; ++j) {
            const f32x4 gg = *((const GAS f32x4*)g + F.lane + 64 * j), bb = *((const GAS f32x4*)b + F.lane + 64 * j);
            const f32x4 y = v[j] * rstd * gg + bb;
            if (outf) *((GAS f32x4*)(outf + (size_t)m * DM) + F.lane + 64 * j) = y;
            if (outb) { v2u w; w.x = pk2(y.x, y.y); w.y = pk2(y.z, y.w); *((GAS v2u*)(outb + (size_t)m * DM) + F.lane + 64 * j) = w; }
        }
    }
}

__device__ __forceinline__ float compute_lam(const float* lq1, const float* lk1, const float* lq2, const float* lk2, int lane) {
    const float a = wave_sum(lq1[lane] * lk1[lane]), b = wave_sum(lq2[lane] * lk2[lane]);
    return expf(a) - expf(b) + LAMBDA_INIT;
}

struct SguArgs { const bf16* sv; bf16* u; const float* lnpart; const float *ln_g, *ln_b, *w_s, *b_s; };
__device__ __forceinline__ void sgu_unit_naive(const Frame& F, const SguArgs& A, int c, int g) {
    LAS float* vn = (LAS float*)F.lds;
    const int tid = F.tid, s = tid >> 2, dq = (tid & 3) * 32; const size_t row = (size_t)c * 128 + s;
    {
        float s1 = 0.f, s2 = 0.f;
#pragma unroll
        for (int p = 0; p < 16; ++p) { const f32x2 t = *(const GAS f32x2*)(A.lnpart + (row * 16 + p) * 2); s1 += t.x; s2 += t.y; }
        const float mean = s1 * (1.f / SGW), var = fmaxf(s2 * (1.f / SGW) - mean * mean, 0.f), rstd = 1.0f / sqrtf(var + LN_EPS);
        const GAS v4u* src = (const GAS v4u*)(A.sv + row * SGW + g * 128 + dq);
#pragma unroll
        for (int q = 0; q < 4; ++q) { const v4u w = src[q]; const int d0 = dq + 8 * q; const int ch = g * 128 + d0;
            float x[8] = {bflo(w.x), bfhi(w.x), bflo(w.y), bfhi(w.y), bflo(w.z), bfhi(w.z), bflo(w.w), bfhi(w.w)};
#pragma unroll
            for (int e = 0; e < 8; ++e) vn[s * 128 + d0 + e] = (x[e] - mean) * rstd * A.ln_g[ch + e] + A.ln_b[ch + e]; }
    }
    __syncthreads();
    const int t = s; float acc[32];
#pragma unroll
    for (int e = 0; e < 32; ++e) acc[e] = 0.f;
    const float* wrow = A.w_s + ((size_t)g * 128 + t) * 128;
    for (int ss = 0; ss < 128; ++ss) { const float w = wrow[ss]; const LAS f32x4* vr = (const LAS f32x4*)(vn + ss * 128 + dq);
#pragma unroll
        for (int q = 0; q < 8; ++q) { const f32x4 v = vr[q]; acc[4 * q] += w * v.x; acc[4 * q + 1] += w * v.y; acc[4 * q + 2] += w * v.z; acc[4 * q + 3] += w * v.w; } }
    const float bs = A.b_s[g * 128 + t];
    GAS v4u* up = (GAS v4u*)(A.u + row * SGW + g * 128 + dq);
#pragma unroll
    for (int q = 0; q < 4; ++q) { const v4u w = up[q]; v4u o;
        o.x = pk2(bflo(w.x) * (acc[8 * q + 0] + bs), bfhi(w.x) * (acc[8 * q + 1] + bs)); o.y = pk2(bflo(w.y) * (acc[8 * q + 2] + bs), bfhi(w.y) * (acc[8 * q + 3] + bs));
        o.z = pk2(bflo(w.z) * (acc[8 * q + 4] + bs), bfhi(w.z) * (acc[8 * q + 5] + bs)); o.w = pk2(bflo(w.w) * (acc[8 * q + 6] + bs), bfhi(w.w) * (acc[8 * q + 7] + bs));
        up[q] = o; }
    __syncthreads();
}

struct AttnArgs { const bf16* q; const bf16* k; const bf16* v; bf16* o; const float* gain; float lam; };
__device__ __forceinline__ void attn_unit_naive(const Frame& F, const AttnArgs& A, int b, int h, int qb) {
    LAS unsigned char* lds = F.lds;
    LAS bf16* Ks = (LAS bf16*)lds; LAS bf16* Vs = (LAS bf16*)(lds + 8192);
    const int tid = F.tid, r = tid & 127, c = (tid >> 7) & 1, half = tid >> 8;
    const size_t rowbase = (size_t)b * SEQ; const int qpos = qb * 128 + r;
    float q[64];
    { const GAS v4u* qp = (const GAS v4u*)(A.q + (rowbase + qpos) * QKW + h * 128 + c * 64);
#pragma unroll
      for (int i = 0; i < 8; ++i) { const v4u w = qp[i]; q[8 * i] = bflo(w.x); q[8 * i + 1] = bfhi(w.x); q[8 * i + 2] = bflo(w.y); q[8 * i + 3] = bfhi(w.y); q[8 * i + 4] = bflo(w.z); q[8 * i + 5] = bfhi(w.z); q[8 * i + 6] = bflo(w.w); q[8 * i + 7] = bfhi(w.w); } }
    float o[64];
#pragma unroll
    for (int d = 0; d < 64; ++d) o[d] = 0.f;
    float m = -1e30f, l = 0.f;
    const float slope2 = __builtin_amdgcn_exp2f(-(float)(h + 1)) * 1.4426950408889634f;
    const int skey = tid >> 4, sch = (tid & 15) * 8;
    for (int kt = 0; kt < SEQ / 32; ++kt) {
        __syncthreads();
        { const size_t grow = (rowbase + (size_t)kt * 32 + skey) * QKW + h * 128 + sch;
          *(LAS v4u*)(Ks + skey * 128 + sch) = *(const GAS v4u*)(A.k + grow);
          *(LAS v4u*)(Vs + skey * 128 + sch) = *(const GAS v4u*)(A.v + grow); }
        __syncthreads();
        for (int j = 0; j < 32; ++j) {
            const LAS v4u* kp = (const LAS v4u*)(Ks + j * 128 + c * 64);
            float dot = 0.f;
#pragma unroll
            for (int i = 0; i < 8; ++i) { const v4u w = kp[i];
                dot += q[8 * i] * bflo(w.x) + q[8 * i + 1] * bfhi(w.x) + q[8 * i + 2] * bflo(w.y) + q[8 * i + 3] * bfhi(w.y) + q[8 * i + 4] * bflo(w.z) + q[8 * i + 5] * bfhi(w.z) + q[8 * i + 6] * bflo(w.w) + q[8 * i + 7] * bfhi(w.w); }
            const float t = dot - slope2 * fabsf((float)(qpos - (kt * 32 + j)));
            const float mn = fmaxf(m, t), al = __builtin_amdgcn_exp2f(m - mn), p = __builtin_amdgcn_exp2f(t - mn);
            l = l * al + p; m = mn;
            const LAS v4u* vp = (const LAS v4u*)(Vs + j * 128 + half * 64);
#pragma unroll
            for (int i = 0; i < 8; ++i) { const v4u w = vp[i];
                o[8 * i] = o[8 * i] * al + p * bflo(w.x); o[8 * i + 1] = o[8 * i + 1] * al + p * bfhi(w.x); o[8 * i + 2] = o[8 * i + 2] * al + p * bflo(w.y); o[8 * i + 3] = o[8 * i + 3] * al + p * bfhi(w.y);
                o[8 * i + 4] = o[8 * i + 4] * al + p * bflo(w.z); o[8 * i + 5] = o[8 * i + 5] * al + p * bfhi(w.z); o[8 * i + 6] = o[8 * i + 6] * al + p * bflo(w.w); o[8 * i + 7] = o[8 * i + 7] * al + p * bfhi(w.w); }
        }
    }
    __syncthreads();
    LAS float* Ax = (LAS float*)lds;
    { const float rl = 1.0f / l; LAS float* dst = Ax + ((size_t)c * 128 + r) * 128 + half * 64;
#pragma unroll
      for (int d = 0; d < 64; ++d) dst[d] = o[d] * rl; }
    __syncthreads();
    { const int r2 = tid >> 2, qd = (tid & 3) * 32; float x[32]; float ss = 0.f;
#pragma unroll
      for (int e = 0; e < 32; ++e) { x[e] = Ax[(size_t)r2 * 128 + qd + e] - A.lam * Ax[(size_t)(128 + r2) * 128 + qd + e]; ss += x[e] * x[e]; }
      ss += __shfl_xor(ss, 1); ss += __shfl_xor(ss, 2);
      const float rstd = 1.0f / sqrtf(ss * (1.f / 128.f) + LN_EPS) * (1.0f - LAMBDA_INIT);
      GAS v4u* op = (GAS v4u*)(A.o + (rowbase + (size_t)qb * 128 + r2) * QKW + h * 128 + qd);
#pragma unroll
      for (int i = 0; i < 4; ++i) { v4u w;
          w.x = pk2(x[8 * i] * rstd * A.gain[qd + 8 * i], x[8 * i + 1] * rstd * A.gain[qd + 8 * i + 1]); w.y = pk2(x[8 * i + 2] * rstd * A.gain[qd + 8 * i + 2], x[8 * i + 3] * rstd * A.gain[qd + 8 * i + 3]);
          w.z = pk2(x[8 * i + 4] * rstd * A.gain[qd + 8 * i + 4], x[8 * i + 5] * rstd * A.gain[qd + 8 * i + 5]); w.w = pk2(x[8 * i + 6] * rstd * A.gain[qd + 8 * i + 6], x[8 * i + 7] * rstd * A.gain[qd + 8 * i + 7]);
          op[i] = w; } }
    __syncthreads();
}


namespace att {
using bf16x8 = __attribute__((ext_vector_type(8))) short;
using s16x4  = __attribute__((ext_vector_type(4))) short;
using f32x16 = __attribute__((ext_vector_type(16))) float;
using u32x4  = __attribute__((ext_vector_type(4))) unsigned;
typedef float f32x2_t __attribute__((ext_vector_type(2))); typedef __bf16 bf16x2_t __attribute__((ext_vector_type(2)));
constexpr int KVBLK = 64, LDQK = 1024;
constexpr int SHM_V = KVBLK * 128 * 2, SHM_K = KVBLK * 128 * 2;
constexpr int OFF_V = 0, OFF_K = 2 * SHM_V, OFF_WS = 2 * SHM_V + 2 * SHM_K, OFF_XCH = OFF_WS + 8 * 64 * 4, ATT_LDS = OFF_XCH + 4 * 32 * 128 * 4;
constexpr float THR2 = 8.0f;
#define KSWZ(row, colB) ((row) * 256 + ((colB) ^ (((row) & 7) << 4)))
#define SBAR() __builtin_amdgcn_sched_barrier(0)
__device__ __forceinline__ int crow(int r, int hi) { return (r & 3) + 8 * (r >> 2) + 4 * hi; }
__device__ __forceinline__ unsigned cvtpk(float lo, float hi) { f32x2_t v = {lo, hi}; bf16x2_t b = __builtin_convertvector(v, bf16x2_t); return __builtin_bit_cast(unsigned, b); }

__device__ __forceinline__ void partialSM(f32x16& p0, f32x16& p1, float kb, float nslope, float& m_reg, float& mn, float& alpha) {
#pragma unroll
  for (int r = 0; r < 16; ++r) { const float cr = (float)((r & 3) + 8 * (r >> 2));
    p0[r] = fmaf(nslope, fabsf(kb + cr), p0[r]); p1[r] = fmaf(nslope, fabsf(kb + (cr + 32.0f)), p1[r]); }
  float pmax = p0[0];
#pragma unroll
  for (int r = 1; r < 16; ++r) pmax = fmaxf(pmax, p0[r]);
#pragma unroll
  for (int r = 0; r < 16; ++r) pmax = fmaxf(pmax, p1[r]);
  { auto rr = __builtin_amdgcn_permlane32_swap(__float_as_uint(pmax), __float_as_uint(pmax), false, false);
    pmax = fmaxf(__uint_as_float(rr[0]), __uint_as_float(rr[1])); }
  if (__builtin_expect(__all(pmax - m_reg <= THR2), 1)) { mn = m_reg; alpha = 1.f; }
  else { mn = fmaxf(m_reg, pmax); alpha = __builtin_amdgcn_exp2f(m_reg - mn); m_reg = mn; }
#pragma unroll
  for (int r = 0; r < 16; ++r) { p0[r] -= mn; p1[r] -= mn; }
#pragma unroll
  for (int r = 0; r < 16; ++r) p0[r] = __builtin_amdgcn_exp2f(p0[r]);
}
__device__ __forceinline__ void finishSM(f32x16& p0, f32x16& p1, float alpha, float& l_reg, bf16x8& pa0, bf16x8& pa1, bf16x8& pa2, bf16x8& pa3) {
#pragma unroll
  for (int r = 0; r < 16; ++r) p1[r] = __builtin_amdgcn_exp2f(p1[r]);
  float ps = 0;
#pragma unroll
  for (int r = 0; r < 16; ++r) ps += p0[r];
#pragma unroll
  for (int r = 0; r < 16; ++r) ps += p1[r];
  { auto rr = __builtin_amdgcn_permlane32_swap(__float_as_uint(ps), __float_as_uint(ps), false, false);
    ps = __uint_as_float(rr[0]) + __uint_as_float(rr[1]); }
  l_reg = l_reg * alpha + ps;
#define PK4(P, BASE, OUT) do { unsigned a0 = cvtpk(P[BASE + 0], P[BASE + 1]), a1 = cvtpk(P[BASE + 2], P[BASE + 3]);   \
    unsigned b0 = cvtpk(P[BASE + 4], P[BASE + 5]), b1 = cvtpk(P[BASE + 6], P[BASE + 7]);                              \
    auto r0 = __builtin_amdgcn_permlane32_swap(a0, b0, false, false); auto r1 = __builtin_amdgcn_permlane32_swap(a1, b1, false, false); \
    u32x4 w = {r0[0], r1[0], r0[1], r1[1]}; OUT = __builtin_bit_cast(bf16x8, w); } while (0)
  PK4(p0, 0, pa0); PK4(p0, 8, pa1); PK4(p1, 0, pa2); PK4(p1, 8, pa3);
#undef PK4
}
__device__ __forceinline__ void qkt(f32x16& p0, f32x16& p1, const LAS char* Ks, const bf16x8* qr, int r32, int cbase) {
  p0 = f32x16{}; p1 = f32x16{};
#pragma unroll
  for (int d0 = 0; d0 < 4; ++d0) { const int cb = cbase + d0 * 32;
    const bf16x8 b0 = *(const LAS bf16x8*)(Ks + KSWZ(r32, cb));
    const bf16x8 b1 = *(const LAS bf16x8*)(Ks + KSWZ(32 + r32, cb));
    p0 = __builtin_amdgcn_mfma_f32_32x32x16_bf16(b0, qr[d0], p0, 0, 0, 0);
    p1 = __builtin_amdgcn_mfma_f32_32x32x16_bf16(b1, qr[d0], p1, 0, 0, 0); }
}
__device__ __forceinline__ int v_st(int k, int c) { const int kk = (k & ~0xC) | ((k & 4) << 1) | ((k & 8) >> 1); return ((kk >> 3) * 4 + (c >> 5)) * 512 + ((kk & 7) * 32 + (c & 31)) * 2; }
__device__ __forceinline__ int v_rd_base(int lane) { return ((lane & 3) << 3) | (((lane >> 2) & 3) << 6) | (((lane >> 4) & 1) << 5) | (((lane >> 5) & 1) << 8); }
constexpr int v_rd_off(int d0, int ks, int half) { return d0 * 512 + ks * 4096 + half * 2048; }
template <int OFF> __device__ __forceinline__ s16x4 tr_read(int vb) {
  s16x4 r; asm volatile("ds_read_b64_tr_b16 %0, %1 offset:%2" : "=&v"(r) : "v"(vb), "i"(OFF) : "memory"); return r;
}
template <int D0> __device__ __forceinline__ void pv_one(f32x16& od, int vb, bf16x8 pa0, bf16x8 pa1, bf16x8 pa2, bf16x8 pa3) {
  const s16x4 l0 = tr_read<v_rd_off(D0, 0, 0)>(vb), h0 = tr_read<v_rd_off(D0, 0, 1)>(vb), l1 = tr_read<v_rd_off(D0, 1, 0)>(vb), h1 = tr_read<v_rd_off(D0, 1, 1)>(vb);
  const s16x4 l2 = tr_read<v_rd_off(D0, 2, 0)>(vb), h2 = tr_read<v_rd_off(D0, 2, 1)>(vb), l3 = tr_read<v_rd_off(D0, 3, 0)>(vb), h3 = tr_read<v_rd_off(D0, 3, 1)>(vb);
  asm volatile("s_waitcnt lgkmcnt(0)" ::: "memory"); SBAR();
#define PK(L, H) (bf16x8){L[0], L[1], L[2], L[3], H[0], H[1], H[2], H[3]}
  od = __builtin_amdgcn_mfma_f32_32x32x16_bf16(pa0, PK(l0, h0), od, 0, 0, 0);
  od = __builtin_amdgcn_mfma_f32_32x32x16_bf16(pa1, PK(l1, h1), od, 0, 0, 0);
  od = __builtin_amdgcn_mfma_f32_32x32x16_bf16(pa2, PK(l2, h2), od, 0, 0, 0);
  od = __builtin_amdgcn_mfma_f32_32x32x16_bf16(pa3, PK(l3, h3), od, 0, 0, 0);
#undef PK
}
__device__ __forceinline__ void pv_d0(f32x16* o, int vb, bf16x8 pa0, bf16x8 pa1, bf16x8 pa2, bf16x8 pa3) {
  pv_one<0>(o[0], vb, pa0, pa1, pa2, pa3); pv_one<1>(o[1], vb, pa0, pa1, pa2, pa3); pv_one<2>(o[2], vb, pa0, pa1, pa2, pa3); pv_one<3>(o[3], vb, pa0, pa1, pa2, pa3);
}

__device__ __forceinline__ void attn_unit(int b, int h, int qb, const bf16* Q, const bf16* __restrict__ K, const bf16* __restrict__ V, bf16* O, const float* gain, float lam, LAS char* lds) {
  const int tid = threadIdx.x, lane = tid & 63, r32 = lane & 31, hi = lane >> 5; const int wid = __builtin_amdgcn_readfirstlane(tid >> 6);
  const int c = wid >> 2, g4 = wid & 3;
  LAS char* V_lds = lds + OFF_V; LAS char* K_lds = lds + OFF_K;
  LAS float* ws = (LAS float*)(lds + OFF_WS) + wid * 64; LAS float* li_l = ws; LAS float* al_l = ws + 32;
  LAS float* xch = (LAS float*)(lds + OFF_XCH) + g4 * (32 * 128);
  const size_t rowbase = (size_t)b * SEQ; const int q0 = qb * 128;
  float m_reg = -1e30f, l_reg = 0.f; f32x16 o[4] = {}; bf16x8 qr[4];
  { const bf16* Qw = Q + (rowbase + q0 + g4 * 32 + r32) * LDQK + h * 128 + c * 64 + hi * 8;
#pragma unroll
    for (int d0 = 0; d0 < 4; ++d0) qr[d0] = *(const GAS bf16x8*)(Qw + d0 * 16); }
  const bf16* Kh = K + rowbase * LDQK + h * 128; const bf16* Vh = V + rowbase * LDQK + h * 128;
  const float nslope = -__builtin_amdgcn_exp2f(-(float)(h + 1)) * 1.4426950408889634f;
  const float kb0 = (float)(4 * hi - (q0 + g4 * 32 + r32));
  const int cbase = c * 128 + hi * 16;
  const int sr = tid >> 4, sc = (tid & 15) * 8, vst0 = v_st(sr, sc), vst1 = v_st(32 + sr, sc);
  const int vb0 = (int)(uintptr_t)V_lds + v_rd_base(lane);
  struct { bf16x8 vs0, vs1, ks0, ks1; } sr_[2];
#define SLOAD(i, k0) do { sr_[i].vs0 = *(const GAS bf16x8*)(&Vh[(size_t)((k0) + sr) * LDQK + sc]); sr_[i].vs1 = *(const GAS bf16x8*)(&Vh[(size_t)((k0) + 32 + sr) * LDQK + sc]); \
    sr_[i].ks0 = *(const GAS bf16x8*)(&Kh[(size_t)((k0) + sr) * LDQK + sc]); sr_[i].ks1 = *(const GAS bf16x8*)(&Kh[(size_t)((k0) + 32 + sr) * LDQK + sc]); } while (0)
#define SWRITE(bb, i) do { *(LAS bf16x8*)(V_lds + (bb) * SHM_V + vst0) = sr_[i].vs0; *(LAS bf16x8*)(V_lds + (bb) * SHM_V + vst1) = sr_[i].vs1; const int kc = sc * 2; \
    *(LAS bf16x8*)(K_lds + (bb) * SHM_K + KSWZ(sr, kc)) = sr_[i].ks0; *(LAS bf16x8*)(K_lds + (bb) * SHM_K + KSWZ(32 + sr, kc)) = sr_[i].ks1; } while (0)
#define SWAIT() asm volatile("s_waitcnt vmcnt(4)" ::: "memory")
#define RESC(a) do { if (__any((a) < 1.f)) { if (hi == 0) al_l[r32] = (a); asm volatile("s_waitcnt lgkmcnt(0)" ::: "memory"); \
    _Pragma("unroll") for (int d = 0; d < 4; ++d) _Pragma("unroll") for (int r = 0; r < 16; ++r) o[d][r] *= al_l[crow(r, hi)]; } } while (0)
  f32x16 pA0, pA1, pB0, pB1; float mnA, mnB, alA, alB; bf16x8 pa0, pa1, pa2, pa3; constexpr int NT = SEQ / KVBLK;
  constexpr int SE = 0, SO = 1;
  SLOAD(SE, 0); asm volatile("s_waitcnt vmcnt(0)" ::: "memory"); SWRITE(0, SE); __syncthreads();
  qkt(pA0, pA1, K_lds, qr, r32, cbase); partialSM(pA0, pA1, kb0, nslope, m_reg, mnA, alA);
  SLOAD(SO, KVBLK); SLOAD(SE, 2 * KVBLK);
  SWAIT(); SWRITE(1, SO); __syncthreads();
  for (int j = 1; j + 1 < NT; j += 2) {
    SBAR(); qkt(pB0, pB1, K_lds + SHM_K, qr, r32, cbase);
    finishSM(pA0, pA1, alA, l_reg, pa0, pa1, pa2, pa3); SBAR();
    SLOAD(SO, (j + 2) * KVBLK); SBAR();
    pv_d0(o, vb0, pa0, pa1, pa2, pa3); partialSM(pB0, pB1, kb0 + (float)(j * KVBLK), nslope, m_reg, mnB, alB);
    __syncthreads(); SWAIT(); SWRITE(0, SE);
    RESC(alB); __syncthreads();
    SBAR(); qkt(pA0, pA1, K_lds, qr, r32, cbase);
    finishSM(pB0, pB1, alB, l_reg, pa0, pa1, pa2, pa3); SBAR();
    if (j + 3 < NT) SLOAD(SE, (j + 3) * KVBLK); SBAR();
    pv_d0(o, vb0 + SHM_V, pa0, pa1, pa2, pa3); partialSM(pA0, pA1, kb0 + (float)((j + 1) * KVBLK), nslope, m_reg, mnA, alA);
    __syncthreads(); SWAIT(); SWRITE(1, SO);
    RESC(alA); __syncthreads();
  }
  SBAR(); qkt(pB0, pB1, K_lds + SHM_K, qr, r32, cbase);
  finishSM(pA0, pA1, alA, l_reg, pa0, pa1, pa2, pa3); SBAR();
  pv_d0(o, vb0, pa0, pa1, pa2, pa3); partialSM(pB0, pB1, kb0 + (float)((NT - 1) * KVBLK), nslope, m_reg, mnB, alB);
  __syncthreads(); RESC(alB);
  finishSM(pB0, pB1, alB, l_reg, pa0, pa1, pa2, pa3); SBAR();
  pv_d0(o, vb0 + SHM_V, pa0, pa1, pa2, pa3);
  int lane_e = threadIdx.x & 63; asm volatile("" : "+v"(lane_e));
  const int r32e = lane_e & 31, hie = lane_e >> 5;
  if (hie == 0) li_l[r32e] = l_reg; asm volatile("s_waitcnt lgkmcnt(0)" ::: "memory");
  float rli[16];
#pragma unroll
  for (int r = 0; r < 16; ++r) rli[r] = __builtin_amdgcn_rcpf(li_l[crow(r, hie)]);
  if (c == 1) {
#pragma unroll
    for (int r = 0; r < 16; ++r) { const float sc1 = rli[r] * lam;
#pragma unroll
      for (int d0 = 0; d0 < 4; ++d0) xch[crow(r, hie) * 128 + d0 * 32 + r32e] = o[d0][r] * sc1; }
  }
  __syncthreads();
  if (c == 0) {
    float gn[4];
#pragma unroll
    for (int d0 = 0; d0 < 4; ++d0) gn[d0] = gain[d0 * 32 + r32e] * (1.0f - LAMBDA_INIT);
    bf16* Ow = O + (rowbase + q0 + g4 * 32) * LDQK + h * 128;
#pragma unroll
    for (int r = 0; r < 16; ++r) { float x[4]; float ss = 0.f;
#pragma unroll
      for (int d0 = 0; d0 < 4; ++d0) { x[d0] = o[d0][r] * rli[r] - xch[crow(r, hie) * 128 + d0 * 32 + r32e]; ss += x[d0] * x[d0]; }
      ss += __shfl_xor(ss, 1); ss += __shfl_xor(ss, 2); ss += __shfl_xor(ss, 4); ss += __shfl_xor(ss, 8); ss += __shfl_xor(ss, 16);
      const float rstd = 1.0f / sqrtf(ss * (1.f / 128.f) + LN_EPS);
#pragma unroll
      for (int d0 = 0; d0 < 4; ++d0) Ow[(size_t)crow(r, hie) * LDQK + d0 * 32 + r32e] = (bf16)f2bf(x[d0] * rstd * gn[d0]); }
  }
  __syncthreads();
#undef SLOAD
#undef SWRITE
#undef SWAIT
#undef RESC
}
#undef KSWZ
#undef SBAR
}

namespace sgu {
using att::bf16x8; using att::f32x16; using att::u32x4;
constexpr int OFF_V = 0, OFF_ST = 32768, OFF_T = 34816, T_LD = 132, SGU_LDS = OFF_T + 128 * T_LD * 4;
struct Args { const bf16* sv; bf16* u; const float* lnpart; const float *ln_g, *ln_b, *w_s, *b_s; bf16* uo; };
__device__ __forceinline__ void sgu_unit(const Args& A, int c, int g, LAS char* lds) {
  const int tid = threadIdx.x, lane = tid & 63, r32 = lane & 31, hi = lane >> 5; const int wid = __builtin_amdgcn_readfirstlane(tid >> 6);
  const int tb = wid & 3, dh = wid >> 2;
  LAS char* V_lds = lds + OFF_V; LAS f32x2* st = (LAS f32x2*)(lds + OFF_ST); LAS float* T = (LAS float*)(lds + OFF_T);
  const size_t row0 = (size_t)c * 128;
  if (tid < 128) { float s1 = 0.f, s2 = 0.f; const GAS f32x4* p = (const GAS f32x4*)(A.lnpart + (row0 + tid) * 32);
#pragma unroll
    for (int q = 0; q < 8; ++q) { const f32x4 t = p[q]; s1 += t.x + t.z; s2 += t.y + t.w; }
    const float mean = s1 * (1.f / SGW), var = fmaxf(s2 * (1.f / SGW) - mean * mean, 0.f);
    st[tid] = (f32x2){mean, 1.0f / sqrtf(var + LN_EPS)}; }
  bf16x8 pa[8];
  { const GAS f32x4* wp = (const GAS f32x4*)(A.w_s + ((size_t)g * 128 + tb * 32 + r32) * 128 + hi * 8);
#pragma unroll
    for (int ks = 0; ks < 8; ++ks) { const f32x4 a = wp[ks * 4], b2 = wp[ks * 4 + 1];
      u32x4 w = {att::cvtpk(a.x, a.y), att::cvtpk(a.z, a.w), att::cvtpk(b2.x, b2.y), att::cvtpk(b2.z, b2.w)}; pa[ks] = __builtin_bit_cast(bf16x8, w); } }
  __syncthreads();
  { const int sr = tid >> 4, sc = (tid & 15) * 8; const int ch = g * 128 + sc;
    const f32x4 g0 = *(const GAS f32x4*)(A.ln_g + ch), g1 = *(const GAS f32x4*)(A.ln_g + ch + 4), b0 = *(const GAS f32x4*)(A.ln_b + ch), b1 = *(const GAS f32x4*)(A.ln_b + ch + 4);
#pragma unroll
    for (int i = 0; i < 4; ++i) { const int s = sr + 32 * i; const f32x2 ms = st[s];
      const v4u w = *(const GAS v4u*)(A.sv + (row0 + s) * SGW + ch);
      const float x0 = (bflo(w.x) - ms.x) * ms.y * g0.x + b0.x, x1 = (bfhi(w.x) - ms.x) * ms.y * g0.y + b0.y, x2 = (bflo(w.y) - ms.x) * ms.y * g0.z + b0.z, x3 = (bfhi(w.y) - ms.x) * ms.y * g0.w + b0.w;
      const float x4 = (bflo(w.z) - ms.x) * ms.y * g1.x + b1.x, x5 = (bfhi(w.z) - ms.x) * ms.y * g1.y + b1.y, x6 = (bflo(w.w) - ms.x) * ms.y * g1.z + b1.z, x7 = (bfhi(w.w) - ms.x) * ms.y * g1.w + b1.w;
      u32x4 o = {att::cvtpk(x0, x1), att::cvtpk(x2, x3), att::cvtpk(x4, x5), att::cvtpk(x6, x7)};
      *(LAS u32x4*)(V_lds + (i >> 1) * att::SHM_V + att::v_st((i & 1) * 32 + sr, sc)) = o; } }
  __syncthreads();
  f32x16 acc[2] = {};
  const int vb0 = (int)(uintptr_t)V_lds + att::v_rd_base(lane);
  if (dh == 0) {
    att::pv_one<0>(acc[0], vb0, pa[0], pa[1], pa[2], pa[3]); att::pv_one<1>(acc[1], vb0, pa[0], pa[1], pa[2], pa[3]);
    att::pv_one<0>(acc[0], vb0 + att::SHM_V, pa[4], pa[5], pa[6], pa[7]); att::pv_one<1>(acc[1], vb0 + att::SHM_V, pa[4], pa[5], pa[6], pa[7]);
  } else {
    att::pv_one<2>(acc[0], vb0, pa[0], pa[1], pa[2], pa[3]); att::pv_one<3>(acc[1], vb0, pa[0], pa[1], pa[2], pa[3]);
    att::pv_one<2>(acc[0], vb0 + att::SHM_V, pa[4], pa[5], pa[6], pa[7]); att::pv_one<3>(acc[1], vb0 + att::SHM_V, pa[4], pa[5], pa[6], pa[7]);
  }
#pragma unroll
  for (int r = 0; r < 16; ++r) { const int t = tb * 32 + att::crow(r, hi); const float bs = A.b_s[g * 128 + t];
#pragma unroll
    for (int k = 0; k < 2; ++k) T[t * T_LD + (2 * dh + k) * 32 + r32] = acc[k][r] + bs; }
  __syncthreads();
  { const int t = tid >> 2, dq = (tid & 3) * 32; GAS v4u* up = (GAS v4u*)(A.u + (row0 + t) * SGW + g * 128 + dq); GAS v4u* uop = (GAS v4u*)(A.uo + (row0 + t) * SGW + g * 128 + dq); const LAS f32x4* tp = (const LAS f32x4*)(T + t * T_LD + dq);
#pragma unroll
    for (int q = 0; q < 4; ++q) { const v4u w = up[q]; const f32x4 m0 = tp[2 * q], m1 = tp[2 * q + 1]; v4u o;
      o.x = att::cvtpk(bflo(w.x) * m0.x, bfhi(w.x) * m0.y); o.y = att::cvtpk(bflo(w.y) * m0.z, bfhi(w.y) * m0.w);
      o.z = att::cvtpk(bflo(w.z) * m1.x, bfhi(w.z) * m1.y); o.w = att::cvtpk(bflo(w.w) * m1.z, bfhi(w.w) * m1.w);
      uop[q] = o; } }
  __syncthreads();
}
}

struct Args { const float* in[21]; float* out; unsigned char* ws; int ph_lo, ph_hi; };
constexpr int N_PHASES = 9;

__global__ void __launch_bounds__(NWAVES * 64, 2) fwd_kernel(Args args) {
    extern __shared__ __attribute__((aligned(16))) unsigned char lds_raw[];
    Frame F;
    F.lds = (LAS unsigned char*)lds_raw;
    F.tid = threadIdx.x; F.lane = F.tid & 63; F.wave = __builtin_amdgcn_readfirstlane(F.tid >> 6);
    F.G = gridDim.x; { const int bx = blockIdx.x; F.vcu = (F.G % 8 == 0) ? (bx % 8) * (F.G / 8) + bx / 8 : bx; }
    unsigned char* ws = args.ws;
    for (int u = F.tid; u < 64; u += NWAVES * 64) ((LAS unsigned*)(F.lds + MISC_OFF))[u] = 0u;
    __syncthreads();
    XcdBarrier bar = xcd_barrier_post((unsigned*)(ws + WS_CTL) + CW_BAR, (volatile LAS unsigned*)(F.lds + MISC_OFF) + 8);
    const float* x = args.in[0];
    bf16* XB = (bf16*)(ws + WS_XB); bf16* QB = (bf16*)(ws + WS_Q); bf16* KB = (bf16*)(ws + WS_K); bf16* VB = (bf16*)(ws + WS_V); bf16* UB = (bf16*)(ws + WS_U); bf16* SVB = (bf16*)(ws + WS_SV);
    bf16* GATES = (bf16*)(ws + WS_GATES); bf16* MERGED = (bf16*)(ws + WS_MERGED); bf16* HB = (bf16*)(ws + WS_H);
    bf16* WIN = (bf16*)(ws + WS_WIN); bf16* WBA = (bf16*)(ws + WS_WBA); bf16* WBS = (bf16*)(ws + WS_WBS); bf16* WO = (bf16*)(ws + WS_WO); bf16* WUP = (bf16*)(ws + WS_WUP); bf16* WDN = (bf16*)(ws + WS_WDN);
    float* LNPART = (float*)(ws + WS_LNPART);
    float* out = args.out;
    const int lo = args.ph_lo, hi = args.ph_hi;
#define IN(k) (lo <= (k) && (k) < hi)
#define SEAM(k) do { if (IN(k) && IN((k) + 1)) { if ((k) == 0 || USE_CG_SYNC) cg::this_grid().sync(); else xcd_barrier(bar); } } while (0)

#if DBG_ZERO & 1
    for (int u = F.tid; u < LDS_BYTES / 4; u += 512) ((LAS unsigned*)F.lds)[u] = 0u;
    __syncthreads();
#endif
    if (IN(0)) {
#if DBG_ZERO & 2
        { const size_t n16 = (WS_END - WS_Q) / 16, nthr = (size_t)F.G * 512; v4u z = {0u, 0u, 0u, 0u};
          for (size_t i = (size_t)F.vcu * 512 + F.tid; i < n16; i += nthr) *((GAS v4u*)(ws + WS_Q) + i) = z; }
#endif
        P0Args A{x, args.in[1], args.in[12], args.in[13], args.in[14], args.in[17], args.in[18], XB, WIN, WBA, WBS, WO, WUP, WDN};
        p0_prologue(F, A);
        if (PROBE_REP & 1) { cg::this_grid().sync(); p0_prologue(F, A); }
    }
    SEAM(0);
    if (IN(1)) {
        pg8::Gemm g{XB, WIN, XB, WIN, NTOK, INW, DM}; pg8::StaticOrder S; S.init(NTOK, INW, F.G, (int)blockIdx.x);
        pg8::EpiInProj E{QB, GATES, args.in[11], LNPART};
        pg8::gemm_phase<pg8::EpiInProj, pg8::StaticOrder, DBG_ALIGN, DBG_SP2>(F.lds, g, S, E);
        if (PROBE_REP & 2) { cg::this_grid().sync(); pg8::gemm_phase<pg8::EpiInProj, pg8::StaticOrder, DBG_ALIGN, DBG_SP2>(F.lds, g, S, E); }
    }
    SEAM(1);
    if (IN(2)) {
        { SguArgs A{SVB, UB, LNPART, args.in[7], args.in[8], args.in[9], args.in[10]};
          for (int it = F.vcu; it < 128 * 8; it += F.G) {
#if SGU_NAIVE
              sgu_unit_naive(F, A, it >> 3, it & 7);
#else
              { const sgu::Args B{A.sv, A.u, A.lnpart, A.ln_g, A.ln_b, A.w_s, A.b_s, A.u}; sgu::sgu_unit(B, it >> 3, it & 7, (LAS char*)F.lds);
                if (PROBE_REP & 4) { const sgu::Args B2{A.sv, A.u, A.lnpart, A.ln_g, A.ln_b, A.w_s, A.b_s, (bf16*)out}; sgu::sgu_unit(B2, it >> 3, it & 7, (LAS char*)F.lds); } }
#endif
          } }
        { AttnArgs A{QB, KB, VB, QB, args.in[6], compute_lam(args.in[2], args.in[3], args.in[4], args.in[5], F.lane)};
          for (int it = F.vcu; it < NB * NH * 32; it += F.G) { const int bh = it >> 5, qb = it & 31;
#if ATTN_NAIVE
              attn_unit_naive(F, A, bh >> 3, bh & 7, qb);
#else
              for (int rep = 0; rep < ((PROBE_REP & 8) ? 2 : 1); ++rep) att::attn_unit(bh >> 3, bh & 7, qb, A.q, A.k, A.v, rep ? (bf16*)out + (size_t)NTOK * 1024 : A.o, A.gain, A.lam, (LAS char*)F.lds);
#endif
          } }
    }
    SEAM(2);
    if (IN(3)) {
        pg8::Gemm g{QB, WBA, UB, WBS, NTOK, DM, 1024}; pg8::TwoPartOrder S; S.init(NTOK, DM, F.G, (int)blockIdx.x);
        pg8::EpiMerge E{GATES, out, MERGED};
        pg8::gemm_phase<pg8::EpiMerge, pg8::TwoPartOrder, true, true>(F.lds, g, S, E);
        if (PROBE_REP & 16) { cg::this_grid().sync(); pg8::gemm_phase<pg8::EpiMerge, pg8::TwoPartOrder, true, true>(F.lds, g, S, E); }
    }
    SEAM(3);
    if (IN(4)) {
        pg8::Gemm g{MERGED, WO, MERGED, WO, NTOK, DM, DM}; pg8::StaticOrder S; S.init(NTOK, DM, F.G, (int)blockIdx.x);
        pg8::EpiResid E{x, out, DN_ALPHA};
        pg8::gemm_phase<pg8::EpiResid, pg8::StaticOrder, true, true>(F.lds, g, S, E);
        if (PROBE_REP & 32) { cg::this_grid().sync(); pg8::gemm_phase<pg8::EpiResid, pg8::StaticOrder, true, true>(F.lds, g, S, E); }
    }
    SEAM(4);
    if (IN(5)) ln_rows(F, out, out, XB, args.in[15], args.in[16]);
    SEAM(5);
    if (IN(6)) {
        pg8::Gemm g{XB, WUP, XB, WUP, NTOK, DFF, DM}; pg8::StaticOrder S; S.init(NTOK, DFF, F.G, (int)blockIdx.x);
        pg8::EpiRelu2 E{HB};
        pg8::gemm_phase<pg8::EpiRelu2, pg8::StaticOrder, true, true>(F.lds, g, S, E);
        if (PROBE_REP & 64) { cg::this_grid().sync(); pg8::gemm_phase<pg8::EpiRelu2, pg8::StaticOrder, true, true>(F.lds, g, S, E); }
    }
    SEAM(6);
    if (IN(7)) {
        pg8::Gemm g{HB, WDN, HB, WDN, NTOK, DM, DFF}; pg8::StaticOrder S; S.init(NTOK, DM, F.G, (int)blockIdx.x);
        pg8::EpiResid E{out, out, DN_ALPHA};
        pg8::gemm_phase<pg8::EpiResid, pg8::StaticOrder, true, true>(F.lds, g, S, E);
    }
    SEAM(7);
    if (PROBE_REP & 128) { for (int i = 0; i < 8; ++i) cg::this_grid().sync(); }
    if (IN(8)) ln_rows(F, out, out, nullptr, args.in[19], args.in[20]);

#if DBG_CUT >= 0
#if MK_N_LAUNCHES == 1
    cg::this_grid().sync();
    {
        const int cut = DBG_CUT;
#else
    if (lo >= 100) {
        const int cut = lo - 100;
#endif
        const size_t n = (size_t)NTOK * DM, nthr = (size_t)F.G * 512;
        for (size_t i = (size_t)F.vcu * 512 + F.tid; i < n; i += nthr) {
            const size_t r = i / DM; const int c = (int)(i % DM); float v = 0.f;
            auto bfv = [](const bf16* p) { return __uint_as_float((unsigned)(*p) << 16); };
            if (cut == 0) { v = bfv(XB + i) + bfv(WIN + (r % 9216) * 2048 + c) + bfv(WUP + (r % 8192) * 2048 + c) + bfv(WDN + (r % 2048) * 8192 + c + 2048 * ((r >> 11) & 3)) + bfv(WO + (r % 2048) * 2048 + c) + bfv(WBA + (r % 2048) * 1024 + (c & 1023)) + bfv(WBS + (r % 2048) * 1024 + (c & 1023)); }
            else if (cut == 1) { for (int k = 0; k < 3; ++k) { const int cc = c + 2048 * k; if (cc < 5120) v += bfv(QB + (size_t)(cc >> 10) * ((size_t)NTOK * 1024) + r * 1024 + (cc & 1023)); }
                            v += bfv(GATES + r * 4096 + c) + bfv(GATES + r * 4096 + 2048 + c); }
            else if (cut == 2) { v = (c < 1024) ? bfv(QB + r * 1024 + c) : bfv(UB + r * 1024 + (c - 1024)); }
            else if (cut == 3) { v = bfv(MERGED + r * 2048 + c); }
            else if (cut == 6) { for (int k = 0; k < 4; ++k) v += bfv(HB + r * 8192 + c + 2048 * k); }
            else continue;
            out[i] = v;
        }
    }
#endif
#undef IN
#undef SEAM
}

extern "C" void kernel_launch(void* const* d_in, const int* in_sizes, int n_in, void* d_out, int out_size, void* d_ws, size_t ws_size, hipStream_t stream) {
    static int grid = 0;
    if (grid == 0) {
        if (n_in != 21 || in_sizes[0] != NTOK * DM || out_size != NTOK * DM || ws_size < WS_END) {
            fprintf(stderr, "kernel_launch: unexpected shapes: n_in %d in0 %d out %d ws %zu (need >= %zu)\n", n_in, n_in > 0 ? in_sizes[0] : -1, out_size, ws_size, (size_t)WS_END); grid = -1; return; }
        int dev = 0, cus = 0, per_cu = 0;
        if (hipGetDevice(&dev) != hipSuccess || hipDeviceGetAttribute(&cus, hipDeviceAttributeMultiprocessorCount, dev) != hipSuccess) { grid = -1; return; }
        if (hipFuncSetAttribute((const void*)fwd_kernel, hipFuncAttributeMaxDynamicSharedMemorySize, LDS_BYTES) != hipSuccess) { fprintf(stderr, "kernel_launch: hipFuncSetAttribute failed\n"); grid = -1; return; }
        if (hipOccupancyMaxActiveBlocksPerMultiprocessor(&per_cu, (const void*)fwd_kernel, NWAVES * 64, LDS_BYTES) != hipSuccess || per_cu < 1) { fprintf(stderr, "kernel_launch: occupancy query says %d blocks per CU\n", per_cu); per_cu = 1; }
        (void)hipGetLastError();
        grid = cus;
        fprintf(stderr, "kernel_launch: %d CUs, occupancy query %d per CU, grid %d\n", cus, per_cu, grid);
    }
    if (grid < 0) return;
    if (hipMemsetAsync((char*)d_ws + WS_CTL, 0, 65536, stream) != hipSuccess) { fprintf(stderr, "kernel_launch: memset failed\n"); return; }
    Args a{};
    for (int i = 0; i < 21; ++i) a.in[i] = (const float*)d_in[i];
    a.out = (float*)d_out; a.ws = (unsigned char*)d_ws;
#if MK_N_LAUNCHES == 1
    a.ph_lo = 0; a.ph_hi = (DBG_CUT >= 0) ? DBG_CUT + 1 : N_PHASES;
    void* kargs[] = {&a};
    hipError_t e = hipLaunchCooperativeKernel((const void*)fwd_kernel, dim3(grid), dim3(NWAVES * 64), kargs, LDS_BYTES, stream);
    if (e != hipSuccess) fprintf(stderr, "kernel_launch: cooperative launch failed: %s (grid %d)\n", hipGetErrorString(e), grid);
#else
#if DBG_CUT >= 0
    for (int p = 0; p <= DBG_CUT; ++p) { a.ph_lo = p; a.ph_hi = p + 1; hipLaunchKernelGGL(fwd_kernel, dim3(grid), dim3(NWAVES * 64), LDS_BYTES, stream, a); }
    a.ph_lo = 100 + DBG_CUT; a.ph_hi = 100 + DBG_CUT; hipLaunchKernelGGL(fwd_kernel, dim3(grid), dim3(NWAVES * 64), LDS_BYTES, stream, a);
#else
    for (int p = 0; p < N_PHASES; ++p) {
        a.ph_lo = p; a.ph_hi = p + 1;
        hipLaunchKernelGGL(fwd_kernel, dim3(grid), dim3(NWAVES * 64), LDS_BYTES, stream, a);
    }
#endif
    const hipError_t le = hipPeekAtLastError();
    if (le != hipSuccess) fprintf(stderr, "kernel_launch: launch failed: %s\n", hipGetErrorName(le));
#endif
}
```
